# Optimizing an MI355X kernel written in HIP

```python
import math
import jax
import jax.numpy as jnp
from jax import lax
import numpy as np

D_MODEL = 1024
BATCH = 1
SEQ = 16384
DEPTH = 4

GRID_W = 64
CTX_LEN = 256

S5_WIDTH = 512
S5_GROUP = 16
S5_GROUPS = S5_WIDTH // S5_GROUP
S5_STATE = 64
S5_DT_MIN = 0.001
S5_DT_MAX = 0.1
FNET_WIDTH = D_MODEL - S5_WIDTH
FNET_GROUPS = 4
FNET_GROUP = FNET_WIDTH // FNET_GROUPS
MIX_WIDTH = S5_WIDTH + FNET_WIDTH

DA_HEADS = 8
DA_HEAD_DIM = 64
DA_V_DIM = 2 * DA_HEAD_DIM
QK_WIDTH = DA_HEADS * 2 * DA_HEAD_DIM
V_WIDTH = DA_HEADS * DA_V_DIM
Q_BLOCK = 128
ROPE_BASE = 10000.0
ROPE_FREQS = DA_HEAD_DIM // 4

N_EXPERTS = 32
TOP_K = 4
D_FF = D_MODEL
SWIGLU_LIMIT = 7.0
SWIGLU_ALPHA = 1.702
EXPERT_BLOCK = 128

N_EVEN = (DEPTH + 1) // 2
N_ODD = DEPTH // 2
DEEPNORM_ALPHA = (2.0 * DEPTH) ** 0.25
DEEPNORM_BETA = (8.0 * DEPTH) ** -0.25
LN_EPS = 1e-5

kernel_name = 'hybrid_s5_fnet_diffattn_moe_dit'


def _layer_norm(x, g, b):
    xf = x.astype(jnp.float32)
    xc = xf - jnp.mean(xf, axis=-1, keepdims=True)
    var = jnp.mean(xc * xc, axis=-1, keepdims=True)
    y = xc * lax.rsqrt(var + LN_EPS) * g.astype(jnp.float32) + b.astype(jnp.float32)
    return y.astype(x.dtype)


def _modulate(x, shift, scale):
    return x * (1.0 + scale) + shift


def _axial_rope_tables(rows, dtype):
    row = jnp.broadcast_to(jnp.arange(rows, dtype=jnp.float32)[:, None], (rows, GRID_W)).reshape(-1)
    col = jnp.broadcast_to(jnp.arange(GRID_W, dtype=jnp.float32)[None, :], (rows, GRID_W)).reshape(-1)
    theta = ROPE_BASE ** (-jnp.arange(ROPE_FREQS, dtype=jnp.float32) / ROPE_FREQS)
    ang = jnp.stack([row[:, None] * theta, col[:, None] * theta], axis=1)
    ang = jnp.stack([ang, ang], axis=2).reshape(rows * GRID_W, DA_HEAD_DIM)
    return jnp.cos(ang).astype(dtype), jnp.sin(ang).astype(dtype)


def _rope_2d(x, cos, sin):
    xr = x.reshape(x.shape[:-1] + (2, 2, ROPE_FREQS))
    rot = jnp.stack([-xr[..., 1, :], xr[..., 0, :]], axis=-2).reshape(x.shape)
    return x * cos + rot * sin


def _ssm_combine(left, right):
    a_l, b_l = left
    a_r, b_r = right
    return a_l * a_r, a_r * b_l + b_r


def _diag_scan(lam_bar, bu, h0, reverse):
    if reverse:
        bu = jnp.flip(bu, axis=1)
    if h0 is not None:
        bu = bu.at[:, 0].add(lam_bar * h0)
    a = jnp.broadcast_to(lam_bar, bu.shape)
    _, h = lax.associative_scan(_ssm_combine, (a, bu), axis=1)
    return jnp.flip(h, axis=1) if reverse else h


def _s5_discretize(lam_re, lam_im, log_dt, b_re, b_im):
    lam = lax.complex(lam_re.astype(jnp.float32), lam_im.astype(jnp.float32))
    dt = jnp.exp(log_dt.astype(jnp.float32))[..., None]
    lam_bar = jnp.exp(lam * dt)
    b = lax.complex(b_re.astype(jnp.float32), b_im.astype(jnp.float32))
    b_bar = ((lam_bar - 1.0) / lam)[..., None] * b
    return lam_bar, b_bar


def _s5_states(u, lam_bar, b_bar, h0_f, h0_b):
    uc = u.astype(jnp.float32).astype(jnp.complex64)
    hf = _diag_scan(lam_bar[0], jnp.einsum('blgc,gnc->blgn', uc, b_bar[0]), h0_f, False)
    hb = _diag_scan(lam_bar[1], jnp.einsum('blgc,gnc->blgn', uc, b_bar[1]), h0_b, True)
    return hf, hb


def _s5_readout(u, hf, hb, c_re, c_im, d_skip):
    c = lax.complex(c_re.astype(jnp.float32), c_im.astype(jnp.float32))
    y = jnp.real(jnp.einsum('blgn,gcn->blgc', hf, c[0]) + jnp.einsum('blgn,gcn->blgc', hb, c[1]))
    return (y + d_skip.astype(jnp.float32) * u.astype(jnp.float32)).astype(u.dtype)


def _fnet_mix(f, w, b):
    ff = f.astype(jnp.float32)
    fc = ff - jnp.mean(ff, axis=-1, keepdims=True)
    fn = fc * lax.rsqrt(jnp.mean(fc * fc, axis=-1, keepdims=True) + LN_EPS)
    spec = jnp.real(jnp.fft.fft2(fn, axes=(1, 3), norm='ortho')).astype(f.dtype)
    return jnp.einsum('blgc,gcd->blgd', spec, w) + b


def _s5_fnet_mixer(h_ctx, h_lat, w_in, lam_re, lam_im, log_dt, b_re, b_im, c_re, c_im, d_skip,
                   w_glu, b_glu, w_fnet, b_fnet, w_out, with_ctx_out):
    lam_bar, b_bar = _s5_discretize(lam_re, lam_im, log_dt, b_re, b_im)

    def split(h):
        z = h @ w_in
        bsz, length = z.shape[:2]
        u = z[..., :S5_WIDTH].reshape(bsz, length, S5_GROUPS, S5_GROUP)
        f = z[..., S5_WIDTH:].reshape(bsz, length, FNET_GROUPS, FNET_GROUP)
        return u, f

    def merge(u, hf, hb, f):
        bsz, length = u.shape[:2]
        y = jax.nn.gelu(_s5_readout(u, hf, hb, c_re, c_im, d_skip).reshape(bsz, length, S5_WIDTH))
        y = y * jax.nn.sigmoid(y @ w_glu + b_glu)
        g = _fnet_mix(f, w_fnet, b_fnet).reshape(bsz, length, FNET_WIDTH)
        return jnp.concatenate([y, g], axis=-1) @ w_out

    u_c, f_c = split(h_ctx)
    u_l, f_l = split(h_lat)
    hf_c, hb_c = _s5_states(u_c, lam_bar, b_bar, None, None)
    hf_l, hb_l = _s5_states(u_l, lam_bar, b_bar, hf_c[:, -1], hb_c[:, 0])
    y_lat = merge(u_l, hf_l, hb_l, f_l)
    y_ctx = merge(u_c, hf_c, hb_c, f_c) if with_ctx_out else None
    return y_ctx, y_lat


def _diff_attend(q, k, v, lam):
    s = jnp.einsum('bhiqd,bhikd->bhiqk', q, k, preferred_element_type=jnp.float32) * (DA_HEAD_DIM ** -0.5)
    p = jax.nn.softmax(s, axis=-1)
    a = p[:, :, 0] - lam * p[:, :, 1]
    return jnp.einsum('bhqk,bhkd->bhqd', a.astype(v.dtype), v)


def _diff_attention_mixer(h_ctx, h_lat, w_qkv, w_o, lq1, lk1, lq2, lk2, subln_g, lam_init,
                          cos, sin, with_ctx_out):
    def project(h):
        z = h @ w_qkv
        bsz, length = z.shape[:2]
        q = z[..., :QK_WIDTH].reshape(bsz, length, DA_HEADS, 2, DA_HEAD_DIM).transpose(0, 2, 3, 1, 4)
        k = z[..., QK_WIDTH:2 * QK_WIDTH].reshape(bsz, length, DA_HEADS, 2, DA_HEAD_DIM).transpose(0, 2, 3, 1, 4)
        v = z[..., 2 * QK_WIDTH:].reshape(bsz, length, DA_HEADS, DA_V_DIM).transpose(0, 2, 1, 3)
        return q, k, v

    lam = (jnp.exp(jnp.sum(lq1.astype(jnp.float32) * lk1.astype(jnp.float32)))
           - jnp.exp(jnp.sum(lq2.astype(jnp.float32) * lk2.astype(jnp.float32))) + lam_init)
    q_c, k_c, v_c = project(h_ctx)
    q_l, k_l, v_l = project(h_lat)
    q_l = _rope_2d(q_l, cos, sin)
    k_l = _rope_2d(k_l, cos, sin)
    k_all = jnp.concatenate([k_c, k_l], axis=3)
    v_all = jnp.concatenate([v_c, v_l], axis=2)

    bsz, _, _, length, _ = q_l.shape
    nb = length // Q_BLOCK
    q_blocks = jnp.moveaxis(q_l.reshape(bsz, DA_HEADS, 2, nb, Q_BLOCK, DA_HEAD_DIM), 3, 0)
    o = lax.map(lambda qb: _diff_attend(qb, k_all, v_all, lam), q_blocks)
    o_lat = jnp.moveaxis(o, 0, 2).reshape(bsz, DA_HEADS, length, DA_V_DIM)

    def finish(o_h):
        of = o_h.astype(jnp.float32)
        of = of * lax.rsqrt(jnp.mean(of * of, axis=-1, keepdims=True) + LN_EPS)
        of = of * subln_g.astype(jnp.float32) * (1.0 - lam_init)
        b_, h_, l_, _ = o_h.shape
        return of.astype(o_h.dtype).transpose(0, 2, 1, 3).reshape(b_, l_, h_ * DA_V_DIM) @ w_o

    y_lat = finish(o_lat)
    y_ctx = finish(_diff_attend(q_c, k_c, v_c, lam)) if with_ctx_out else None
    return y_ctx, y_lat


def _moe(h, w_router, b_router, w_gate, b_gate, w_up, b_up, w_down, b_down):
    lead = h.shape[:-1]
    hf = h.reshape(-1, D_MODEL)
    n = hf.shape[0]
    logits = (hf @ w_router + b_router).astype(jnp.float32)
    top_val, top_idx = lax.top_k(logits, TOP_K)
    top_w = jax.nn.softmax(top_val, axis=-1)
    e_flat = top_idx.reshape(-1)
    tok_flat = jnp.repeat(jnp.arange(n, dtype=jnp.int32), TOP_K)
    w_flat = top_w.reshape(-1)
    order = jnp.argsort(e_flat)
    e_s, tok_s, w_s = e_flat[order], tok_flat[order], w_flat[order]
    counts = jnp.bincount(e_flat, length=N_EXPERTS)
    start = jnp.cumsum(counts) - counts
    padded = (counts + EXPERT_BLOCK - 1) // EXPERT_BLOCK * EXPERT_BLOCK
    pad_end = jnp.cumsum(padded)
    pad_start = pad_end - padded
    nk = n * TOP_K
    dest = pad_start[e_s] + jnp.arange(nk, dtype=pad_start.dtype) - start[e_s]
    n_blocks = -(-nk // EXPERT_BLOCK) + N_EXPERTS
    cap = n_blocks * EXPERT_BLOCK
    x_disp = jnp.zeros((cap, D_MODEL), h.dtype).at[dest].set(hf[tok_s])
    blk_e = jnp.minimum(jnp.searchsorted(pad_end, jnp.arange(n_blocks, dtype=pad_end.dtype) * EXPERT_BLOCK,
                                         side='right'), N_EXPERTS - 1)

    def expert_block(args):
        xb, e = args
        g = jnp.minimum(xb @ w_gate[e] + b_gate[e], SWIGLU_LIMIT)
        u = jnp.clip(xb @ w_up[e] + b_up[e], -SWIGLU_LIMIT, SWIGLU_LIMIT)
        return (g * jax.nn.sigmoid(SWIGLU_ALPHA * g) * (u + 1.0)) @ w_down[e] + b_down[e]

    y_disp = lax.map(expert_block, (x_disp.reshape(n_blocks, EXPERT_BLOCK, D_MODEL), blk_e))
    y_disp = y_disp.reshape(cap, D_MODEL)
    y = jnp.zeros_like(hf).at[tok_s].add(y_disp[dest] * w_s[:, None].astype(h.dtype))
    return y.reshape(lead + (D_MODEL,))


def setup_inputs(seed: int = 0) -> dict:
    key = jax.random.key(seed)
    ks = jax.random.split(key, 37)
    f32 = jnp.float32

    def nrm(i, shape, scale):
        return jax.random.normal(ks[i], shape, f32) * scale

    beta = DEEPNORM_BETA
    lam_im = math.pi * jnp.arange(S5_STATE, dtype=f32) + nrm(10, (N_EVEN, 2, S5_GROUPS, S5_STATE), 0.01)
    return {
        'x': nrm(0, (BATCH, SEQ, D_MODEL), 1.0),
        'c': nrm(1, (BATCH, D_MODEL), 1.0),
        'ctx': nrm(2, (BATCH, CTX_LEN, D_MODEL), 1.0),
        'c_ctx': nrm(3, (D_MODEL,), 1.0),
        'ada_w': nrm(4, (DEPTH, D_MODEL, 6 * D_MODEL), 0.5 * D_MODEL ** -0.5),
        'ada_b': nrm(5, (DEPTH, 6 * D_MODEL), 0.02),
        'ln_g': 1.0 + nrm(6, (DEPTH, 2, D_MODEL), 0.02),
        'ln_b': nrm(7, (DEPTH, 2, D_MODEL), 0.02),
        'even_w_in': nrm(8, (N_EVEN, D_MODEL, MIX_WIDTH), D_MODEL ** -0.5),
        's5_lam_re': -0.5 + nrm(9, (N_EVEN, 2, S5_GROUPS, S5_STATE), 0.01),
        's5_lam_im': lam_im,
        's5_log_dt': jax.random.uniform(ks[11], (N_EVEN, 2, S5_GROUPS), f32,
                                        math.log(S5_DT_MIN), math.log(S5_DT_MAX)),
        's5_b_re': nrm(12, (N_EVEN, 2, S5_GROUPS, S5_STATE, S5_GROUP), (2.0 * S5_GROUP) ** -0.5),
        's5_b_im': nrm(13, (N_EVEN, 2, S5_GROUPS, S5_STATE, S5_GROUP), (2.0 * S5_GROUP) ** -0.5),
        's5_c_re': nrm(14, (N_EVEN, 2, S5_GROUPS, S5_GROUP, S5_STATE), S5_STATE ** -0.5),
        's5_c_im': nrm(15, (N_EVEN, 2, S5_GROUPS, S5_GROUP, S5_STATE), S5_STATE ** -0.5),
        's5_d': nrm(16, (N_EVEN, S5_GROUPS, S5_GROUP), 0.5),
        's5_w_glu': nrm(17, (N_EVEN, S5_WIDTH, S5_WIDTH), S5_WIDTH ** -0.5),
        's5_b_glu': nrm(18, (N_EVEN, S5_WIDTH), 0.02),
        'fnet_w': nrm(19, (N_EVEN, FNET_GROUPS, FNET_GROUP, FNET_GROUP), FNET_GROUP ** -0.5),
        'fnet_b': nrm(20, (N_EVEN, FNET_GROUPS, FNET_GROUP), 0.02),
        'even_w_out': nrm(21, (N_EVEN, MIX_WIDTH, D_MODEL), beta * MIX_WIDTH ** -0.5),
        'odd_w_qkv': nrm(22, (N_ODD, D_MODEL, 2 * QK_WIDTH + V_WIDTH), D_MODEL ** -0.5),
        'odd_w_o': nrm(23, (N_ODD, V_WIDTH, D_MODEL), beta * V_WIDTH ** -0.5),
        'da_lq1': nrm(24, (N_ODD, DA_HEAD_DIM), 0.1),
        'da_lk1': nrm(25, (N_ODD, DA_HEAD_DIM), 0.1),
        'da_lq2': nrm(26, (N_ODD, DA_HEAD_DIM), 0.1),
        'da_lk2': nrm(27, (N_ODD, DA_HEAD_DIM), 0.1),
        'da_subln_g': 1.0 + nrm(28, (N_ODD, DA_V_DIM), 0.02),
        'router_w': nrm(29, (DEPTH, D_MODEL, N_EXPERTS), D_MODEL ** -0.5),
        'router_b': nrm(30, (DEPTH, N_EXPERTS), 0.01),
        'moe_w_gate': nrm(31, (DEPTH, N_EXPERTS, D_MODEL, D_FF), D_MODEL ** -0.5),
        'moe_b_gate': nrm(32, (DEPTH, N_EXPERTS, D_FF), 0.02),
        'moe_w_up': nrm(33, (DEPTH, N_EXPERTS, D_MODEL, D_FF), D_MODEL ** -0.5),
        'moe_b_up': nrm(34, (DEPTH, N_EXPERTS, D_FF), 0.02),
        'moe_w_down': nrm(35, (DEPTH, N_EXPERTS, D_FF, D_MODEL), beta * D_FF ** -0.5),
        'moe_b_down': nrm(36, (DEPTH, N_EXPERTS, D_MODEL), 0.02),
    }


def reference(x, c, ctx, c_ctx, ada_w, ada_b, ln_g, ln_b, even_w_in, s5_lam_re, s5_lam_im, s5_log_dt,
              s5_b_re, s5_b_im, s5_c_re, s5_c_im, s5_d, s5_w_glu, s5_b_glu, fnet_w, fnet_b, even_w_out,
              odd_w_qkv, odd_w_o, da_lq1, da_lk1, da_lq2, da_lk2, da_subln_g, router_w, router_b,
              moe_w_gate, moe_b_gate, moe_w_up, moe_b_up, moe_w_down, moe_b_down):
    rows = x.shape[1] // GRID_W
    cos, sin = _axial_rope_tables(rows, x.dtype)
    cond_lat = jax.nn.silu(c)[:, None, :]
    cond_ctx = jax.nn.silu(c_ctx)
    n_ctx = ctx.shape[1]
    for l in range(DEPTH):
        last = l == DEPTH - 1
        i = l // 2
        mod_l = jnp.split(cond_lat @ ada_w[l] + ada_b[l], 6, axis=-1)
        mod_c = jnp.split(cond_ctx @ ada_w[l] + ada_b[l], 6, axis=-1)
        h_l = _modulate(x, mod_l[0], mod_l[1])
        h_c = _modulate(ctx, mod_c[0], mod_c[1])
        if l % 2 == 0:
            y_c, y_l = _s5_fnet_mixer(h_c, h_l, even_w_in[i], s5_lam_re[i], s5_lam_im[i], s5_log_dt[i],
                                      s5_b_re[i], s5_b_im[i], s5_c_re[i], s5_c_im[i], s5_d[i],
                                      s5_w_glu[i], s5_b_glu[i], fnet_w[i], fnet_b[i], even_w_out[i],
                                      not last)
        else:
            lam_init = 0.8 - 0.6 * math.exp(-0.3 * l)
            y_c, y_l = _diff_attention_mixer(h_c, h_l, odd_w_qkv[i], odd_w_o[i], da_lq1[i], da_lk1[i],
                                             da_lq2[i], da_lk2[i], da_subln_g[i], lam_init, cos, sin,
                                             not last)
        x = _layer_norm(DEEPNORM_ALPHA * x + mod_l[2] * y_l, ln_g[l, 0], ln_b[l, 0])
        h_l = _modulate(x, mod_l[3], mod_l[4])
        moe_args = (router_w[l], router_b[l], moe_w_gate[l], moe_b_gate[l], moe_w_up[l], moe_b_up[l],
                    moe_w_down[l], moe_b_down[l])
        if last:
            y_l = _moe(h_l, *moe_args)
        else:
            ctx = _layer_norm(DEEPNORM_ALPHA * ctx + mod_c[2] * y_c, ln_g[l, 0], ln_b[l, 0])
            h_c = _modulate(ctx, mod_c[3], mod_c[4])
            y_all = _moe(jnp.concatenate([h_c, h_l], axis=1), *moe_args)
            y_c, y_l = y_all[:, :n_ctx], y_all[:, n_ctx:]
            ctx = _layer_norm(DEEPNORM_ALPHA * ctx + mod_c[5] * y_c, ln_g[l, 1], ln_b[l, 1])
        x = _layer_norm(DEEPNORM_ALPHA * x + mod_l[5] * y_l, ln_g[l, 1], ln_b[l, 1])
    return x
```

```cpp
#include <hip/hip_runtime.h>
#include <cstdio>
#include <cstdint>

#define LAS __attribute__((address_space(3)))
#define GAS __attribute__((address_space(1)))
typedef unsigned short bf16_t;
typedef short bf16x8 __attribute__((ext_vector_type(8)));
typedef short s16x4 __attribute__((ext_vector_type(4)));
typedef float f32x4 __attribute__((ext_vector_type(4)));
typedef float f32x2 __attribute__((ext_vector_type(2)));
typedef float f32x16 __attribute__((ext_vector_type(16)));
typedef unsigned u32x4 __attribute__((ext_vector_type(4)));
typedef unsigned u32x2 __attribute__((ext_vector_type(2)));

constexpr int DM = 1024, SEQ = 16384, CTX = 256, NTOK = SEQ + CTX;
constexpr int NEXP = 32, TOPK = 4;
constexpr int S5G = 32, S5C = 16, S5N = 64, CHT = 32, NCH = NTOK / CHT  , NCH_CTX = CTX / CHT  , NCHP = 768;
constexpr int UPW = 768;
constexpr float LN_EPS = 1e-5f;
constexpr float DN_ALPHA = 1.681792830507429f;

__device__ __forceinline__ unsigned cvt_pk_bf16(float lo, float hi) { unsigned r; asm volatile("v_cvt_pk_bf16_f32 %0, %1, %2" : "=v"(r) : "v"(lo), "v"(hi)); return r; }
__device__ __forceinline__ float bf2f(unsigned short b) { return __uint_as_float(((unsigned)b) << 16); }
__device__ __forceinline__ float bflo(unsigned w) { return __uint_as_float(w << 16); }
__device__ __forceinline__ float bfhi(unsigned w) { return __uint_as_float(w & 0xffff0000u); }
__device__ __forceinline__ float fast_sigmoid(float x) { return __builtin_amdgcn_rcpf(1.0f + __builtin_amdgcn_exp2f(-1.4426950408889634f * x)); }

namespace pg8 {
constexpr int BM = 256, BK = 64, HALF = 128, HTB = HALF * BK * 2, STAGE_BYTES = 8 * HTB;
__host__ __device__ __forceinline__ int lds_byte(int r, int c) { const int st = (r >> 4) * 2 + (c >> 5), rr = r & 15, cc = c & 31, ob = rr * 64 + cc * 2; return st * 1024 + (ob ^ (((ob >> 9) & 1) << 5)); }
__host__ __device__ __forceinline__ void stage_rc(int b, int& R, int& C) { const int st = b / 1024, sb = b % 1024, swz = sb ^ (((sb >> 9) & 1) << 5); R = (st >> 1) * 16 + swz / 64; C = (st & 1) * 32 + (swz % 64) / 2; }
__host__ __device__ __forceinline__ int perm32(int rho) { const int n = rho >> 4, i = rho & 15; return 8 * (i >> 2) + 4 * n + (i & 3); }

struct Unit { int pm, pn, z, aux; };

template <class Epi, class Sched>
__device__ __forceinline__ void gemm_phase(LAS unsigned char* lds, const Sched& S, const Epi& E) {
    int tid_ = threadIdx.x; asm volatile("" : "+v"(tid_));
    const int tid = tid_, wid = __builtin_amdgcn_readfirstlane(tid >> 6), lane = tid & 63, wr = wid >> 2, wc = wid & 3, fr = lane & 15, fq = lane >> 4;
    const int K = S.K, nt = K / BK, ldb = S.ldb;
    constexpr bool GA = Sched::GATHER;
    int Rr[2], Cc[2]; unsigned voffB[2];
#pragma unroll
    for (int i = 0; i < 2; ++i) { int R, C; stage_rc(tid * 16 + i * 8192, R, C); Rr[i] = R; Cc[i] = C * 2; const int Rb = Epi::PERM ? ((R & ~31) + perm32(R & 31)) : R; voffB[i] = (unsigned)(Rb * ldb + C) * 2u; }
    const size_t kstep = (size_t)(BK * 2);
    const size_t hstepB = (size_t)HALF * ldb * 2;
    const unsigned ldsw = (unsigned)wid * 1024u;
    const int aoff = lds_byte(wr * 64 + fr, fq * 8), boff = lds_byte(wc * 32 + fr, fq * 8);
#define PG8_SA(b, h) (((b) * 2 + (h)) * HTB)
#define PG8_SB(b, h) ((4 + (b) * 2 + (h)) * HTB)
#define PG8_STAGEB(bufoff, gbase) do { _Pragma("unroll") for (int _i = 0; _i < 2; ++_i) \
        __builtin_amdgcn_global_load_lds((const unsigned*)((const char*)(gbase) + voffB[_i]), (LAS unsigned*)(lds + (bufoff) + ldsw + _i * 8192), 16, 0, 0); } while (0)
#define PG8_STAGEA(bufoff, gbase, ro) do { _Pragma("unroll") for (int _i = 0; _i < 2; ++_i) \
        __builtin_amdgcn_global_load_lds((const unsigned*)((const char*)(gbase) + (ro)[_i]), (LAS unsigned*)(lds + (bufoff) + ldsw + _i * 8192), 16, 0, 0); } while (0)
#define PG8_LDA(dst, b, h) do { _Pragma("unroll") for (int m = 0; m < 4; ++m) _Pragma("unroll") for (int k = 0; k < 2; ++k) dst[m][k] = *(const LAS bf16x8*)(lds + PG8_SA(b, h) + aoff + m * 2048 + k * 1024); } while (0)
#define PG8_LDB(dst, b, h) do { _Pragma("unroll") for (int n = 0; n < 2; ++n) _Pragma("unroll") for (int k = 0; k < 2; ++k) dst[n][k] = *(const LAS bf16x8*)(lds + PG8_SB(b, h) + boff + n * 2048 + k * 1024); } while (0)
#define PG8_MMA(ai, bj, At, Bt) do { __builtin_amdgcn_s_setprio(1); _Pragma("unroll") for (int m = 0; m < 4; ++m) _Pragma("unroll") for (int n = 0; n < 2; ++n) _Pragma("unroll") for (int k = 0; k < 2; ++k) \
        acc[ai][bj][m][n] = __builtin_amdgcn_mfma_f32_16x16x32_bf16(Bt[n][k], At[m][k], acc[ai][bj][m][n], 0, 0, 0); __builtin_amdgcn_s_setprio(0); } while (0)
#define PG8_WAIT_V(n) asm volatile("s_waitcnt vmcnt(" #n ")" ::: "memory")
#define PG8_WAIT_L(n) asm volatile("s_waitcnt lgkmcnt(" #n ")" ::: "memory")
#define PG8_BAR __builtin_amdgcn_s_barrier()
#define PG8_SCHED __builtin_amdgcn_sched_barrier(0)
    Unit cur, nxt; int ui = 0;
    if (!S.next(0, cur)) return;
    f32x4 acc[2][2][4][2];
#pragma unroll
    for (int a = 0; a < 2; ++a)
#pragma unroll
        for (int b = 0; b < 2; ++b)
#pragma unroll
            for (int m = 0; m < 4; ++m)
#pragma unroll
                for (int n = 0; n < 2; ++n) acc[a][b][m][n] = (f32x4){0.f, 0.f, 0.f, 0.f};
    bf16x8 At[4][2], B0[2][2], B1[2][2];
    unsigned ar0[2], ar1[2], nr0[2], nr1[2];
#pragma unroll
    for (int i = 0; i < 2; ++i) { ar0[i] = S.a_row(cur, Rr[i]) + (unsigned)Cc[i]; ar1[i] = S.a_row(cur, HALF + Rr[i]) + (unsigned)Cc[i]; nr0[i] = ar0[i]; nr1[i] = ar1[i]; }
    const char* cA = S.a_base(cur); const char* cB = S.b_base(cur);
    PG8_WAIT_V(0);
    PG8_STAGEB(PG8_SB(0, 0), cB); PG8_STAGEB(PG8_SB(0, 1), cB + hstepB); PG8_STAGEA(PG8_SA(0, 0), cA, ar0); PG8_STAGEA(PG8_SA(0, 1), cA, ar1);
    if (wr == 1) PG8_BAR;
    PG8_WAIT_V(2); PG8_BAR;
    PG8_STAGEB(PG8_SB(1, 0), cB + kstep); PG8_STAGEA(PG8_SA(1, 0), cA + kstep, ar0); PG8_STAGEB(PG8_SB(1, 1), cB + hstepB + kstep);
    PG8_WAIT_V(6); PG8_BAR;
    for (;;) {
        const bool has_next = S.next(ui + 1, nxt);
        const char* nA = has_next ? S.a_base(nxt) : cA; const char* nB = has_next ? S.b_base(nxt) : cB;
        if constexpr (GA) {
#pragma unroll
        for (int i = 0; i < 2; ++i) { nr0[i] = has_next ? S.a_row(nxt, Rr[i]) + (unsigned)Cc[i] : ar0[i]; nr1[i] = has_next ? S.a_row(nxt, HALF + Rr[i]) + (unsigned)Cc[i] : ar1[i]; }
        }
        for (int t = 0; t < nt; t += 2) {
            const bool last = (t == nt - 2);
            const char* a1 = cA + (size_t)(t + 1) * kstep;
            const char* a2 = last ? nA : cA + (size_t)(t + 2) * kstep; const char* b2 = last ? nB : cB + (size_t)(t + 2) * kstep;
            const char* a3 = a2 + kstep; const char* b3 = b2 + kstep;
            unsigned s0[2], s1[2];
#pragma unroll
            for (int i = 0; i < 2; ++i) { s0[i] = (GA && last) ? nr0[i] : ar0[i]; s1[i] = (GA && last) ? nr1[i] : ar1[i]; }
            PG8_LDB(B0, 0, 0); PG8_LDB(B1, 0, 1); PG8_SCHED; PG8_LDA(At, 0, 0); PG8_STAGEA(PG8_SA(1, 1), a1, ar1);
            PG8_WAIT_V(8); PG8_WAIT_L(0); PG8_BAR; PG8_MMA(0, 0, At, B0); PG8_MMA(0, 1, At, B1); PG8_BAR; PG8_SCHED;
            PG8_LDA(At, 0, 1); PG8_STAGEB(PG8_SB(0, 0), b2); PG8_STAGEB(PG8_SB(0, 1), b2 + hstepB); PG8_STAGEA(PG8_SA(0, 0), a2, s0);
            PG8_WAIT_V(8); PG8_WAIT_L(0); PG8_BAR; PG8_MMA(1, 0, At, B0); PG8_MMA(1, 1, At, B1); PG8_BAR; PG8_SCHED;
            PG8_LDB(B0, 1, 0); PG8_LDB(B1, 1, 1); PG8_SCHED; PG8_LDA(At, 1, 0); PG8_STAGEA(PG8_SA(0, 1), a2, s1);
            PG8_WAIT_V(8); PG8_WAIT_L(0); PG8_BAR; PG8_MMA(0, 0, At, B0); PG8_MMA(0, 1, At, B1); PG8_BAR; PG8_SCHED;
            PG8_LDA(At, 1, 1); PG8_STAGEB(PG8_SB(1, 0), b3); PG8_STAGEB(PG8_SB(1, 1), b3 + hstepB); PG8_STAGEA(PG8_SA(1, 0), a3, s0);
            PG8_WAIT_V(8); PG8_WAIT_L(0); PG8_BAR; PG8_MMA(1, 0, At, B0); PG8_MMA(1, 1, At, B1); PG8_BAR; PG8_SCHED;
        }
        if (wr == 0) PG8_BAR;
        E(acc, cur, wr, wc, fr, fq);
        if (!has_next) break;
#pragma unroll
        for (int a = 0; a < 2; ++a)
#pragma unroll
            for (int b = 0; b < 2; ++b)
#pragma unroll
                for (int m = 0; m < 4; ++m)
#pragma unroll
                    for (int n = 0; n < 2; ++n) acc[a][b][m][n] = (f32x4){0.f, 0.f, 0.f, 0.f};
        cur = nxt; cA = nA; cB = nB; ++ui;
        if constexpr (GA) {
#pragma unroll
        for (int i = 0; i < 2; ++i) { ar0[i] = nr0[i]; ar1[i] = nr1[i]; }
        }
        if (wr == 1) PG8_BAR;
    }
    PG8_WAIT_V(0);
    PG8_BAR;
#undef PG8_SA
#undef PG8_SB
#undef PG8_STAGEA
#undef PG8_STAGEB
#undef PG8_LDA
#undef PG8_LDB
#undef PG8_MMA
#undef PG8_WAIT_V
#undef PG8_WAIT_L
#undef PG8_BAR
#undef PG8_SCHED
}
}
namespace pg8 {
struct DenseSched {
    static constexpr bool GATHER = false;
    const bf16_t* A; const bf16_t* Bt; int K, lda, ldb;
    int nM, nN, nwg, G, c;
    __device__ __forceinline__ void init(const bf16_t* A_, int lda_, const bf16_t* Bt_, int ldb_, int M, int N, int K_, int G_, int c_) {
        A = A_; Bt = Bt_; K = K_; lda = lda_; ldb = ldb_; nM = M / BM; nN = N / BM; nwg = nM * nN; G = G_; c = c_; }
    __device__ __forceinline__ bool next(int i, Unit& u) const {
        const long L = (long)i * G + c; if (L >= nwg) return false;
        int wgid = (int)L; { const int q = nwg / 8, r = nwg % 8, xcd = wgid % 8, off = wgid / 8; wgid = (xcd < r ? xcd * (q + 1) : r * (q + 1) + (xcd - r) * q) + off; }
        const int nig = 8 * nN, gid = wgid / nig, fm = gid * 8, gsz = (nM - fm) < 8 ? (nM - fm) : 8;
        u.pm = fm + ((wgid % nig) % gsz); u.pn = (wgid % nig) / gsz; u.z = 0; u.aux = 0; return true;
    }
    __device__ __forceinline__ const char* a_base(const Unit& u) const { return (const char*)A + (size_t)u.pm * BM * lda * 2; }
    __device__ __forceinline__ unsigned a_row(const Unit&, int r) const { return (unsigned)r * (unsigned)lda * 2u; }
    __device__ __forceinline__ const char* b_base(const Unit& u) const { return (const char*)Bt + (size_t)u.pn * BM * ldb * 2; }
};
struct BatchSched {
    static constexpr bool GATHER = false;
    const bf16_t* A; const bf16_t* Bt; size_t sA, sB; int K, lda, ldb;
    int nM, nN, nZ, G, c;
    __device__ __forceinline__ void init(const bf16_t* A_, size_t sA_, int lda_, const bf16_t* Bt_, size_t sB_, int ldb_, int nM_, int nN_, int nZ_, int K_, int G_, int c_) {
        A = A_; Bt = Bt_; sA = sA_; sB = sB_; K = K_; lda = lda_; ldb = ldb_; nM = nM_; nN = nN_; nZ = nZ_; G = G_; c = c_; }
    __device__ __forceinline__ bool next(int i, Unit& u) const {
        const int L = i * G + c; if (L >= nM * nN * nZ) return false;
        u.z = L / (nM * nN); const int r = L % (nM * nN); u.pm = r / nN; u.pn = r % nN; u.aux = 0; return true;
    }
    __device__ __forceinline__ const char* a_base(const Unit& u) const { return (const char*)(A + (size_t)u.z * sA) + (size_t)u.pm * BM * lda * 2; }
    __device__ __forceinline__ unsigned a_row(const Unit&, int r) const { return (unsigned)r * (unsigned)lda * 2u; }
    __device__ __forceinline__ const char* b_base(const Unit& u) const { return (const char*)(Bt + (size_t)u.z * sB) + (size_t)u.pn * BM * ldb * 2; }
};
template <bool GATHER_> struct MoeSched {
    static constexpr bool GATHER = GATHER_;
    const bf16_t* A; const bf16_t* Bt; size_t sB; int K, lda, ldb, nN, G, c;
    const LAS int* tp; const LAS int* cnt; const int* list;
    __device__ __forceinline__ bool next(int i, Unit& u) const {
        const int L = i * G + c; const int ntile = tp[NEXP]; if (L >= ntile * nN) return false;
        const int T = L / nN; u.pn = L % nN; int e = 0;
#pragma unroll 1
        for (int s = 16; s > 0; s >>= 1) if (tp[e + s] <= T) e += s;
        u.z = e; u.pm = T; u.aux = T - tp[e]; return true;
    }
    __device__ __forceinline__ const char* a_base(const Unit& u) const { return GATHER ? (const char*)A : (const char*)A + (size_t)u.pm * BM * lda * 2; }
    __device__ __forceinline__ unsigned a_row(const Unit& u, int r) const {
        if (GATHER) { const int idx = u.aux * BM + r; const int tok = list[u.z * NTOK + (idx < cnt[u.z] ? idx : 0)]; return (unsigned)tok * (unsigned)lda * 2u; }
        return (unsigned)r * (unsigned)lda * 2u;
    }
    __device__ __forceinline__ const char* b_base(const Unit& u) const { return (const char*)(Bt + (size_t)u.z * sB) + (size_t)u.pn * BM * ldb * 2; }
};

#define EPI_ROW(u, ai, m) ((u).pm * BM + (ai) * HALF + wr * 64 + (m) * 16 + fr)
#define EPI_COL8(u, bj) ((u).pn * BM + (bj) * HALF + wc * 32 + 8 * fq)
#define EPI_FOR_AM _Pragma("unroll") for (int ai = 0; ai < 2; ++ai) _Pragma("unroll") for (int m = 0; m < 4; ++m)
__device__ __forceinline__ u32x4 pack8(f32x4 v0, f32x4 v1) { u32x4 w; w.x = cvt_pk_bf16(v0[0], v0[1]); w.y = cvt_pk_bf16(v0[2], v0[3]); w.z = cvt_pk_bf16(v1[0], v1[1]); w.w = cvt_pk_bf16(v1[2], v1[3]); return w; }

struct EpiZ {
    static constexpr bool PERM = true;
    bf16_t* UP; bf16_t* ZF;
    __device__ __forceinline__ void operator()(const f32x4 (&acc)[2][2][4][2], const Unit& u, int wr, int wc, int fr, int fq) const {
        EPI_FOR_AM { const int row = EPI_ROW(u, ai, m);
#pragma unroll
            for (int bj = 0; bj < 2; ++bj) { const int col = EPI_COL8(u, bj); const u32x4 w = pack8(acc[ai][bj][m][0], acc[ai][bj][m][1]);
                if (u.pn < 2) { const int g = col >> 4, c0 = col & 15, j = row >> 5, i = row & 31; *(u32x4*)(UP + ((size_t)g * NCHP + j) * UPW + i * 16 + c0) = w; }
                else *(u32x4*)(ZF + (size_t)row * 512 + (col - 512)) = w; } }
    }
};
struct EpiG1 {
    static constexpr bool PERM = true;
    float* SLOC;
    __device__ __forceinline__ void operator()(const f32x4 (&acc)[2][2][4][2], const Unit& u, int wr, int wc, int fr, int fq) const {
        EPI_FOR_AM { const int row = EPI_ROW(u, ai, m); if (row < NCH) {
#pragma unroll
            for (int bj = 0; bj < 2; ++bj) { const int col = EPI_COL8(u, bj); float* p = SLOC + ((size_t)u.z * NCH + row) * 256 + col;
                *(f32x4*)p = acc[ai][bj][m][0]; *(f32x4*)(p + 4) = acc[ai][bj][m][1]; } } }
    }
};
__device__ __forceinline__ float gelu_tanh(float x) { const float t = 1.5957691216057308f * (x + 0.044715f * x * x * x); return x * fast_sigmoid(t); }
struct EpiG2 {
    static constexpr bool PERM = true;
    bf16_t* YG;
    __device__ __forceinline__ void operator()(const f32x4 (&acc)[2][2][4][2], const Unit& u, int wr, int wc, int fr, int fq) const {
        EPI_FOR_AM { const int row = EPI_ROW(u, ai, m); if (row < NCH) {
#pragma unroll
            for (int bj = 0; bj < 2; ++bj) { const int col = EPI_COL8(u, bj); const int i = col >> 4, c0 = col & 15; f32x4 v0 = acc[ai][bj][m][0], v1 = acc[ai][bj][m][1];
#pragma unroll
                for (int e = 0; e < 4; ++e) { v0[e] = gelu_tanh(v0[e]); v1[e] = gelu_tanh(v1[e]); }
                *(u32x4*)(YG + (size_t)(row * CHT + i) * 512 + u.z * 16 + c0) = pack8(v0, v1); } } }
    }
};
struct EpiBias16 {
    static constexpr bool PERM = true;
    bf16_t* O; int ldo, coff; const float* bias; int bstride;
    __device__ __forceinline__ void operator()(const f32x4 (&acc)[2][2][4][2], const Unit& u, int wr, int wc, int fr, int fq) const {
        const float* bp = bias + (size_t)u.z * bstride;
        f32x4 bv[2][2];
#pragma unroll
        for (int bj = 0; bj < 2; ++bj) { const int col = EPI_COL8(u, bj); bv[bj][0] = *(const f32x4*)(bp + col); bv[bj][1] = *(const f32x4*)(bp + col + 4); }
        EPI_FOR_AM { const int row = EPI_ROW(u, ai, m);
#pragma unroll
            for (int bj = 0; bj < 2; ++bj) { const int col = EPI_COL8(u, bj);
                *(u32x4*)(O + (size_t)row * ldo + coff + col) = pack8(acc[ai][bj][m][0] + bv[bj][0], acc[ai][bj][m][1] + bv[bj][1]); } }
    }
};
struct EpiGLU {
    static constexpr bool PERM = true;
    const bf16_t* YG; bf16_t* CAT; const float* bias;
    __device__ __forceinline__ void operator()(const f32x4 (&acc)[2][2][4][2], const Unit& u, int wr, int wc, int fr, int fq) const {
        f32x4 bv[2][2];
#pragma unroll
        for (int bj = 0; bj < 2; ++bj) { const int col = EPI_COL8(u, bj); bv[bj][0] = *(const f32x4*)(bias + col); bv[bj][1] = *(const f32x4*)(bias + col + 4); }
        EPI_FOR_AM { const int row = EPI_ROW(u, ai, m);
#pragma unroll
            for (int bj = 0; bj < 2; ++bj) { const int col = EPI_COL8(u, bj); const u32x4 yw = *(const u32x4*)(YG + (size_t)row * 512 + col);
                f32x4 v0 = acc[ai][bj][m][0] + bv[bj][0], v1 = acc[ai][bj][m][1] + bv[bj][1];
                v0[0] = bflo(yw.x) * fast_sigmoid(v0[0]); v0[1] = bfhi(yw.x) * fast_sigmoid(v0[1]); v0[2] = bflo(yw.y) * fast_sigmoid(v0[2]); v0[3] = bfhi(yw.y) * fast_sigmoid(v0[3]);
                v1[0] = bflo(yw.z) * fast_sigmoid(v1[0]); v1[1] = bfhi(yw.z) * fast_sigmoid(v1[1]); v1[2] = bflo(yw.w) * fast_sigmoid(v1[2]); v1[3] = bfhi(yw.w) * fast_sigmoid(v1[3]);
                *(u32x4*)(CAT + (size_t)row * 1024 + col) = pack8(v0, v1); } }
    }
};
struct EpiRes {
    static constexpr bool PERM = true;
    float* X; const float* gate_lat; const float* gate_ctx;
    __device__ __forceinline__ void operator()(const f32x4 (&acc)[2][2][4][2], const Unit& u, int wr, int wc, int fr, int fq) const {
        const float* gp = (u.pm == 0) ? gate_ctx : gate_lat;
        f32x4 gv[2][2];
#pragma unroll
        for (int bj = 0; bj < 2; ++bj) { const int col = EPI_COL8(u, bj); gv[bj][0] = *(const f32x4*)(gp + col); gv[bj][1] = *(const f32x4*)(gp + col + 4); }
        EPI_FOR_AM { const int row = EPI_ROW(u, ai, m);
#pragma unroll
            for (int bj = 0; bj < 2; ++bj) { const int col = EPI_COL8(u, bj); float* p = X + (size_t)row * DM + col;
                const f32x4 x0 = *(const f32x4*)p, x1 = *(const f32x4*)(p + 4);
                *(f32x4*)p = x0 * DN_ALPHA + gv[bj][0] * acc[ai][bj][m][0]; *(f32x4*)(p + 4) = x1 * DN_ALPHA + gv[bj][1] * acc[ai][bj][m][1]; } }
    }
};
struct EpiQKV {
    static constexpr bool PERM = false;
    bf16_t* QKV; const float* rope;
    __device__ __forceinline__ void operator()(const f32x4 (&acc)[2][2][4][2], const Unit& u, int wr, int wc, int fr, int fq) const {
        const bool do_rope = (u.pn < 8) && (u.pm > 0);
        EPI_FOR_AM { const int row = EPI_ROW(u, ai, m);
            f32x4 cs = {1.f, 1.f, 1.f, 1.f}, sn = {0.f, 0.f, 0.f, 0.f};
            if (do_rope) { const int t = row - CTX; const int pos = (wc & 1) ? (t & 63) : (t >> 6); const float* rp = rope + (size_t)pos * 32 + 8 * fq;
                const f32x4 a = *(const f32x4*)rp, b = *(const f32x4*)(rp + 4); cs = (f32x4){a[0], a[2], b[0], b[2]}; sn = (f32x4){a[1], a[3], b[1], b[3]}; }
#pragma unroll
            for (int bj = 0; bj < 2; ++bj) { const f32x4 x0 = acc[ai][bj][m][0], x1 = acc[ai][bj][m][1];
                const f32x4 o0 = x0 * cs - x1 * sn, o1 = x1 * cs + x0 * sn;
                const int col = u.pn * BM + bj * HALF + wc * 32 + 4 * fq; bf16_t* p = QKV + (size_t)row * 3072 + col;
                u32x2 w0, w1; w0.x = cvt_pk_bf16(o0[0], o0[1]); w0.y = cvt_pk_bf16(o0[2], o0[3]); w1.x = cvt_pk_bf16(o1[0], o1[1]); w1.y = cvt_pk_bf16(o1[2], o1[3]);
                *(u32x2*)p = w0; *(u32x2*)(p + 16) = w1; } }
    }
};
struct EpiSwiGLU {
    static constexpr bool PERM = true;
    bf16_t* ACT; const float* bg; const float* bu;
    __device__ __forceinline__ void operator()(const f32x4 (&acc)[2][2][4][2], const Unit& u, int wr, int wc, int fr, int fq) const {
        const int oc = u.pn * HALF + wc * 32 + 8 * fq;
        const float* pg = bg + (size_t)u.z * 1024 + oc; const float* pu = bu + (size_t)u.z * 1024 + oc;
        const f32x4 g0 = *(const f32x4*)pg, g1 = *(const f32x4*)(pg + 4), u0 = *(const f32x4*)pu, u1 = *(const f32x4*)(pu + 4);
        EPI_FOR_AM { const int row = EPI_ROW(u, ai, m);
            f32x4 a0 = acc[ai][0][m][0] + g0, a1 = acc[ai][0][m][1] + g1, b0 = acc[ai][1][m][0] + u0, b1 = acc[ai][1][m][1] + u1;
#pragma unroll
            for (int e = 0; e < 4; ++e) { float g = fminf(a0[e], 7.f), uu = fminf(fmaxf(b0[e], -7.f), 7.f); a0[e] = g * fast_sigmoid(1.702f * g) * (uu + 1.f);
                g = fminf(a1[e], 7.f); uu = fminf(fmaxf(b1[e], -7.f), 7.f); a1[e] = g * fast_sigmoid(1.702f * g) * (uu + 1.f); }
            *(u32x4*)(ACT + (size_t)row * 1024 + oc) = pack8(a0, a1); }
    }
};
}
__device__ __forceinline__ float wave_sum(float v) {
#pragma unroll
    for (int o = 1; o < 64; o <<= 1) v += __shfl_xor(v, o);
    return v;
}
__device__ __forceinline__ int brev7(int x) { return (int)(__brev((unsigned)x) >> 25); }

constexpr int FT_LD = 129;
template <bool DIM0> __device__ __forceinline__ void fft128(f32x2* T, const f32x2* tw, const int tid) {
    const int line = tid & 127, part = tid >> 7;
    const int sF = DIM0 ? FT_LD : 1, sL = DIM0 ? 1 : FT_LD;
    f32x2* base = T + line * sL;
#pragma unroll 1
    for (int half = 64; half >= 1; half >>= 1) {
        const int tstep = 64 / half;
#pragma unroll 4
        for (int q = 0; q < 16; ++q) {
            const int bf = part * 16 + q, k = bf & (half - 1), blk = bf / half, r0 = blk * 2 * half + k;
            const f32x2 a = base[r0 * sF], b = base[(r0 + half) * sF], w = tw[k * tstep];
            const f32x2 s = a + b, d = a - b;
            base[r0 * sF] = s;
            base[(r0 + half) * sF] = (f32x2){d.x * w.x - d.y * w.y, d.x * w.y + d.y * w.x};
        }
        __syncthreads();
    }
}
__device__ __forceinline__ void fft_a_unit(const bf16_t* ZF, f32x2* TT, int row0, int rstride, int g, float tw_turns  , float scale, f32x2* T, const f32x2* tw, const int tid) {
#pragma unroll
    for (int it = 0; it < 4; ++it) {
        const int p = tid + 512 * it, l1 = p >> 4, ch = (p & 15) * 8;
        const u32x4 w = *(const u32x4*)(ZF + (size_t)(row0 + rstride * l1) * 512 + g * 128 + ch);
        float v[8] = {bflo(w.x), bfhi(w.x), bflo(w.y), bfhi(w.y), bflo(w.z), bfhi(w.z), bflo(w.w), bfhi(w.w)};
        float s = 0.f;
#pragma unroll
        for (int e = 0; e < 8; ++e) s += v[e];
#pragma unroll
        for (int o = 1; o < 16; o <<= 1) s += __shfl_xor(s, o);
        const float mean = s * (1.f / 128.f); float q = 0.f;
#pragma unroll
        for (int e = 0; e < 8; ++e) { v[e] -= mean; q += v[e] * v[e]; }
#pragma unroll
        for (int o = 1; o < 16; o <<= 1) q += __shfl_xor(q, o);
        const float rstd = 1.0f / sqrtf(q * (1.f / 128.f) + LN_EPS);
#pragma unroll
        for (int e = 0; e < 8; ++e) T[l1 * FT_LD + ch + e] = (f32x2){v[e] * rstd, 0.f};
    }
    __syncthreads();
    fft128<false>(T, tw, tid);
    fft128<true>(T, tw, tid);
#pragma unroll 4
    for (int it = 0; it < 32; ++it) {
        const int p = tid + 512 * it, k1 = p >> 7, kc = p & 127;
        const f32x2 v = T[brev7(k1) * FT_LD + brev7(kc)];
        float sn, cs; sincospif(-2.0f * tw_turns * (float)k1, &sn, &cs);
        cs *= scale; sn *= scale;
        TT[(size_t)(row0 + rstride * k1) * 512 + g * 128 + kc] = (f32x2){v.x * cs - v.y * sn, v.x * sn + v.y * cs};
    }
    __syncthreads();
}
__device__ __forceinline__ void fft_b_unit(const f32x2* TT, bf16_t* SPEC, int in_row0, int out_row0, int g, f32x2* T, const f32x2* tw, const int tid) {
#pragma unroll 4
    for (int it = 0; it < 32; ++it) { const int p = tid + 512 * it, l2 = p >> 7, kc = p & 127; T[l2 * FT_LD + kc] = TT[(size_t)(in_row0 + l2) * 512 + g * 128 + kc]; }
    __syncthreads();
    fft128<true>(T, tw, tid);
#pragma unroll
    for (int it = 0; it < 4; ++it) {
        const int p = tid + 512 * it, k2 = p >> 4, kc = (p & 15) * 8; const f32x2* s = T + brev7(k2) * FT_LD + kc;
        u32x4 w; w.x = cvt_pk_bf16(s[0].x, s[1].x); w.y = cvt_pk_bf16(s[2].x, s[3].x); w.z = cvt_pk_bf16(s[4].x, s[5].x); w.w = cvt_pk_bf16(s[6].x, s[7].x);
        *(u32x4*)(SPEC + (size_t)(out_row0 + 128 * k2) * 512 + g * 128 + kc) = w;
    }
    __syncthreads();
}
namespace attn {
constexpr int NW = 8, QBLK = 32, KVBLK = 64, LDQ = 3072;
constexpr float SCALE = 0.125f;
constexpr float THR = 8.f;
constexpr int SHM_V = KVBLK * 128 * 2, SHM_K = KVBLK * 64 * 2, SHM_ATTN = 2 * SHM_V + 2 * SHM_K + NW * 64 * 4;
#define ASBAR() __builtin_amdgcn_sched_barrier(0)
#define KSWZ64(row, colB) ((row) * 128 + ((colB) ^ ((((row) >> 1) & 7) << 4)))
__device__ __forceinline__ int crow(int r, int hi) { return (r & 3) + 8 * (r >> 2) + 4 * hi; }
__device__ __forceinline__ void partialSM(f32x16& p0, f32x16& p1, float& m_reg, float& mn, float& alpha) {
  constexpr float C = SCALE * 1.4426950408889634f;
  float pmax = p0[0];
#pragma unroll
  for (int r = 1; r < 16; ++r) pmax = fmaxf(pmax, p0[r]);
#pragma unroll
  for (int r = 0; r < 16; ++r) pmax = fmaxf(pmax, p1[r]);
  { auto rr = __builtin_amdgcn_permlane32_swap(__float_as_uint(pmax), __float_as_uint(pmax), false, false);
    pmax = fmaxf(__uint_as_float(rr[0]), __uint_as_float(rr[1])); }
  if (__builtin_expect(__all(pmax - m_reg <= THR / SCALE), 1)) { mn = m_reg; alpha = 1.f; }
  else { mn = fmaxf(m_reg, pmax); alpha = __builtin_amdgcn_exp2f((m_reg - mn) * C); m_reg = mn; }
  const float mnC = -mn * C;
#pragma unroll
  for (int r = 0; r < 16; ++r) p0[r] = fmaf(p0[r], C, mnC);
#pragma unroll
  for (int r = 0; r < 16; ++r) p1[r] = fmaf(p1[r], C, mnC);
#pragma unroll
  for (int r = 0; r < 16; ++r) p0[r] = __builtin_amdgcn_exp2f(p0[r]);
}
__device__ __forceinline__ void finishSM(f32x16& p0, f32x16& p1, float alpha, float& l_reg, bf16x8& pa0, bf16x8& pa1, bf16x8& pa2, bf16x8& pa3) {
#pragma unroll
  for (int r = 0; r < 16; ++r) p1[r] = __builtin_amdgcn_exp2f(p1[r]);
  float ps = 0;
#pragma unroll
  for (int r = 0; r < 16; ++r) ps += p0[r];
#pragma unroll
  for (int r = 0; r < 16; ++r) ps += p1[r];
  { auto rr = __builtin_amdgcn_permlane32_swap(__float_as_uint(ps), __float_as_uint(ps), false, false);
    ps = __uint_as_float(rr[0]) + __uint_as_float(rr[1]); }
  l_reg = l_reg * alpha + ps;
#define PK4(P, BASE, OUT) do { unsigned a0 = cvt_pk_bf16(P[BASE + 0], P[BASE + 1]), a1 = cvt_pk_bf16(P[BASE + 2], P[BASE + 3]);   \
    unsigned b0 = cvt_pk_bf16(P[BASE + 4], P[BASE + 5]), b1 = cvt_pk_bf16(P[BASE + 6], P[BASE + 7]);                              \
    auto r0 = __builtin_amdgcn_permlane32_swap(a0, b0, false, false); auto r1 = __builtin_amdgcn_permlane32_swap(a1, b1, false, false); \
    u32x4 w = {r0[0], r1[0], r0[1], r1[1]}; OUT = *reinterpret_cast<bf16x8*>(&w); } while (0)
  PK4(p0, 0, pa0); PK4(p0, 8, pa1); PK4(p1, 0, pa2); PK4(p1, 8, pa3);
#undef PK4
}
__device__ __forceinline__ void qkt(f32x16& p0, f32x16& p1, const char* Ks, const bf16x8* qr, int r32, int hi) {
  p0 = f32x16{}; p1 = f32x16{};
#pragma unroll
  for (int d0 = 0; d0 < 4; ++d0) { const int cb = (d0 * 16 + hi * 8) * 2;
    const bf16x8 b0 = *reinterpret_cast<const bf16x8*>(Ks + KSWZ64(r32, cb));
    const bf16x8 b1 = *reinterpret_cast<const bf16x8*>(Ks + KSWZ64(32 + r32, cb));
    p0 = __builtin_amdgcn_mfma_f32_32x32x16_bf16(b0, qr[d0], p0, 0, 0, 0);
    p1 = __builtin_amdgcn_mfma_f32_32x32x16_bf16(b1, qr[d0], p1, 0, 0, 0); }
}
__device__ __forceinline__ int v_st(int k, int c) { const int kk = (k & ~0xC) | ((k & 4) << 1) | ((k & 8) >> 1); return ((kk >> 3) * 4 + (c >> 5)) * 512 + ((kk & 7) * 32 + (c & 31)) * 2; }
__device__ __forceinline__ int v_rd_base(int lane) { return ((lane & 3) << 3) | (((lane >> 2) & 3) << 6) | (((lane >> 4) & 1) << 5) | (((lane >> 5) & 1) << 8); }
constexpr int v_rd_off(int d0, int ks, int half) { return d0 * 512 + ks * 4096 + half * 2048; }
template <int OFF> __device__ __forceinline__ s16x4 tr_read(int vb) {
  s16x4 r; asm volatile("ds_read_b64_tr_b16 %0, %1 offset:%2" : "=&v"(r) : "v"(vb), "i"(OFF) : "memory"); return r;
}
template <int D0> __device__ __forceinline__ void pv_one(f32x16& od, int vb, bf16x8 pa0, bf16x8 pa1, bf16x8 pa2, bf16x8 pa3) {
  const s16x4 l0 = tr_read<v_rd_off(D0, 0, 0)>(vb), h0 = tr_read<v_rd_off(D0, 0, 1)>(vb), l1 = tr_read<v_rd_off(D0, 1, 0)>(vb), h1 = tr_read<v_rd_off(D0, 1, 1)>(vb);
  const s16x4 l2 = tr_read<v_rd_off(D0, 2, 0)>(vb), h2 = tr_read<v_rd_off(D0, 2, 1)>(vb), l3 = tr_read<v_rd_off(D0, 3, 0)>(vb), h3 = tr_read<v_rd_off(D0, 3, 1)>(vb);
  asm volatile("s_waitcnt lgkmcnt(0)" ::: "memory"); ASBAR();
#define PK(L, H) (bf16x8){L[0], L[1], L[2], L[3], H[0], H[1], H[2], H[3]}
  od = __builtin_amdgcn_mfma_f32_32x32x16_bf16(pa0, PK(l0, h0), od, 0, 0, 0);
  od = __builtin_amdgcn_mfma_f32_32x32x16_bf16(pa1, PK(l1, h1), od, 0, 0, 0);
  od = __builtin_amdgcn_mfma_f32_32x32x16_bf16(pa2, PK(l2, h2), od, 0, 0, 0);
  od = __builtin_amdgcn_mfma_f32_32x32x16_bf16(pa3, PK(l3, h3), od, 0, 0, 0);
#undef PK
}
__device__ __forceinline__ void pv_d0(f32x16* o, int vb, bf16x8 pa0, bf16x8 pa1, bf16x8 pa2, bf16x8 pa3) {
  pv_one<0>(o[0], vb, pa0, pa1, pa2, pa3); pv_one<1>(o[1], vb, pa0, pa1, pa2, pa3); pv_one<2>(o[2], vb, pa0, pa1, pa2, pa3); pv_one<3>(o[3], vb, pa0, pa1, pa2, pa3);
}
__device__ __forceinline__ void attn_unit(const bf16_t* __restrict__ Qb, const bf16_t* __restrict__ Kh, const bf16_t* __restrict__ Vh, float* __restrict__ Ob, int ldo, int seq, char* lds, const int tid) {
  const int wid = tid >> 6, lane = tid & 63, r32 = lane & 31, hi = lane >> 5;
  char* V_lds = lds; char* K_lds = lds + 2 * SHM_V;
  float* ws = (float*)(lds + 2 * SHM_V + 2 * SHM_K) + wid * 64; float* li_l = ws; float* al_l = ws + 32;
  float m_reg = -1e30f, l_reg = 0; f32x16 o[4] = {}; bf16x8 qr[4];
  const bf16_t* Qw = Qb + (long)(wid * QBLK + r32) * LDQ + hi * 8;
#pragma unroll
  for (int d0 = 0; d0 < 4; ++d0) qr[d0] = *reinterpret_cast<const bf16x8*>(Qw + d0 * 16);
  const int sr = tid >> 4, sc = (tid & 15) * 8, vst0 = v_st(sr, sc), vst1 = v_st(32 + sr, sc);
  const int ksr = tid >> 3, ksc = (tid & 7) * 8, kst = KSWZ64(ksr, ksc * 2);
  const int vb0 = (int)(uintptr_t)V_lds + v_rd_base(lane);
  struct { bf16x8 vs0, vs1, ks0; } sr_[2];
#define SLOAD(i, k0) do { sr_[i].vs0 = *reinterpret_cast<const bf16x8*>(&Vh[(long)((k0) + sr) * LDQ + sc]); sr_[i].vs1 = *reinterpret_cast<const bf16x8*>(&Vh[(long)((k0) + 32 + sr) * LDQ + sc]); \
    sr_[i].ks0 = *reinterpret_cast<const bf16x8*>(&Kh[(long)((k0) + ksr) * LDQ + ksc]); } while (0)
#define SWRITE(b, i) do { *(bf16x8*)(V_lds + (b) * SHM_V + vst0) = sr_[i].vs0; *(bf16x8*)(V_lds + (b) * SHM_V + vst1) = sr_[i].vs1; \
    *(bf16x8*)(K_lds + (b) * SHM_K + kst) = sr_[i].ks0; } while (0)
#define SWAIT() asm volatile("s_waitcnt vmcnt(3)" ::: "memory")
#define RESC(a) do { if (__any((a) < 1.f)) { if (hi == 0) al_l[r32] = (a); asm volatile("s_waitcnt lgkmcnt(0)" ::: "memory"); \
    _Pragma("unroll") for (int d = 0; d < 4; ++d) _Pragma("unroll") for (int r = 0; r < 16; ++r) o[d][r] *= al_l[crow(r, hi)]; } } while (0)
  f32x16 pA0, pA1, pB0, pB1; float mnA, mnB, alA, alB; bf16x8 pa0, pa1, pa2, pa3; const int NT = seq / KVBLK;
  constexpr int SE = 0, SO = 1;
  SLOAD(SE, 0); asm volatile("s_waitcnt vmcnt(0)" ::: "memory"); SWRITE(0, SE); __syncthreads();
  qkt(pA0, pA1, K_lds, qr, r32, hi); partialSM(pA0, pA1, m_reg, mnA, alA);
  SLOAD(SO, KVBLK); if (2 < NT) SLOAD(SE, 2 * KVBLK);
  SWAIT(); SWRITE(1, SO); __syncthreads();
  for (int j = 1; j + 1 < NT; j += 2) {
    ASBAR(); qkt(pB0, pB1, K_lds + SHM_K, qr, r32, hi);
    finishSM(pA0, pA1, alA, l_reg, pa0, pa1, pa2, pa3); ASBAR();
    SLOAD(SO, (j + 2) * KVBLK); ASBAR();
    pv_d0(o, vb0, pa0, pa1, pa2, pa3); partialSM(pB0, pB1, m_reg, mnB, alB);
    __syncthreads(); SWAIT(); SWRITE(0, SE);
    RESC(alB); __syncthreads();
    ASBAR(); qkt(pA0, pA1, K_lds, qr, r32, hi);
    finishSM(pB0, pB1, alB, l_reg, pa0, pa1, pa2, pa3); ASBAR();
    if (j + 3 < NT) SLOAD(SE, (j + 3) * KVBLK); ASBAR();
    pv_d0(o, vb0 + SHM_V, pa0, pa1, pa2, pa3); partialSM(pA0, pA1, m_reg, mnA, alA);
    __syncthreads(); SWAIT(); SWRITE(1, SO);
    RESC(alA); __syncthreads();
  }
  ASBAR(); qkt(pB0, pB1, K_lds + SHM_K, qr, r32, hi);
  finishSM(pA0, pA1, alA, l_reg, pa0, pa1, pa2, pa3); ASBAR();
  pv_d0(o, vb0, pa0, pa1, pa2, pa3); partialSM(pB0, pB1, m_reg, mnB, alB);
  __syncthreads(); RESC(alB);
  finishSM(pB0, pB1, alB, l_reg, pa0, pa1, pa2, pa3); ASBAR();
  pv_d0(o, vb0 + SHM_V, pa0, pa1, pa2, pa3);
  if (hi == 0) li_l[r32] = l_reg; asm volatile("s_waitcnt lgkmcnt(0)" ::: "memory");
  float rli[16];
#pragma unroll
  for (int r = 0; r < 16; ++r) rli[r] = __builtin_amdgcn_rcpf(li_l[crow(r, hi)]);
  float* Ow = Ob + (long)(wid * QBLK) * ldo;
#pragma unroll
  for (int r = 0; r < 16; ++r) { const int orow = crow(r, hi);
#pragma unroll
    for (int d0 = 0; d0 < 4; ++d0) Ow[(long)orow * ldo + d0 * 32 + r32] = o[d0][r] * rli[r]; }
  __syncthreads();
#undef SLOAD
#undef SWRITE
#undef SWAIT
#undef RESC
}
}
__device__ __forceinline__ int scan_chunk(int dir, int s) { return dir == 0 ? s : (s < NCH_CTX ? NCH_CTX - 1 - s : NCH - 1 - (s - NCH_CTX)); }
__device__ __forceinline__ void s5_scan_thread(int gt  , const float* SLOC, const f32x2* APOW, bf16_t* UP) {
    const int n = gt & 63, g = (gt >> 6) & 31, dir = gt >> 11;
    const f32x2 A = APOW[gt];
    const float* sl = SLOC + (size_t)g * NCH * 256 + dir * 128 + n;
    bf16_t* up = UP + (size_t)g * NCHP * UPW + 512 + dir * 128 + n;
    float hr = 0.f, hi = 0.f;
    constexpr int BATCH = 26;
#pragma unroll 1
    for (int s0 = 0; s0 < NCH; s0 += BATCH) {
        float sr[BATCH], si[BATCH];
#pragma unroll
        for (int b = 0; b < BATCH; ++b) { const int ch = scan_chunk(dir, s0 + b); sr[b] = sl[(size_t)ch * 256]; si[b] = sl[(size_t)ch * 256 + 64]; }
#pragma unroll
        for (int b = 0; b < BATCH; ++b) { const int ch = scan_chunk(dir, s0 + b);
            up[(size_t)ch * UPW] = (bf16_t)(cvt_pk_bf16(hr, 0.f) & 0xffffu); up[(size_t)ch * UPW + 64] = (bf16_t)(cvt_pk_bf16(hi, 0.f) & 0xffffu);
            const float nr = A.x * hr - A.y * hi + sr[b], ni = A.x * hi + A.y * hr + si[b]; hr = nr; hi = ni; }
    }
}

__device__ __forceinline__ void ln_router_row(int row, float* X, bf16_t* H2, const float* lng, const float* lnb, const float* shift, const float* scale,
                                              const float* wr_lds, const float* br, int* TOPI, float* TOPW, int* TOPS, int* LIST, unsigned* cnt, int lane) {
    f32x4* xr = (f32x4*)(X + (size_t)row * DM) + lane;
    f32x4 v[4]; float s = 0.f;
#pragma unroll
    for (int j = 0; j < 4; ++j) { v[j] = xr[64 * j]; s += (v[j][0] + v[j][1]) + (v[j][2] + v[j][3]); }
    const float mean = wave_sum(s) * (1.f / DM); float s2 = 0.f;
#pragma unroll
    for (int j = 0; j < 4; ++j) { v[j] = v[j] - mean; s2 += (v[j][0] * v[j][0] + v[j][1] * v[j][1]) + (v[j][2] * v[j][2] + v[j][3] * v[j][3]); }
    const float rstd = 1.f / sqrtf(wave_sum(s2) * (1.f / DM) + LN_EPS);
    f32x4 h[4];
#pragma unroll
    for (int j = 0; j < 4; ++j) { const int c = 4 * lane + 256 * j;
        const f32x4 g = *(const f32x4*)(lng + c), b = *(const f32x4*)(lnb + c), sh = *(const f32x4*)(shift + c), sc = *(const f32x4*)(scale + c);
        v[j] = v[j] * rstd * g + b; xr[64 * j] = v[j];
        h[j] = v[j] * (sc + 1.0f) + sh;
        u32x2 w; w.x = cvt_pk_bf16(h[j][0], h[j][1]); w.y = cvt_pk_bf16(h[j][2], h[j][3]);
        *(u32x2*)(H2 + (size_t)row * DM + c) = w; }
    float lg[NEXP];
#pragma unroll
    for (int e = 0; e < NEXP; ++e) { float a = 0.f;
#pragma unroll
        for (int j = 0; j < 4; ++j) { const f32x4 w = *(const f32x4*)(wr_lds + e * DM + 4 * lane + 256 * j); a += (h[j][0] * w[0] + h[j][1] * w[1]) + (h[j][2] * w[2] + h[j][3] * w[3]); }
        lg[e] = a; }
#pragma unroll
    for (int e = 0; e < NEXP; ++e) lg[e] = wave_sum(lg[e]) + br[e];
    int ti[TOPK]; float tv[TOPK];
#pragma unroll
    for (int k = 0; k < TOPK; ++k) { float best = -3.0e38f; int bi = 0;
#pragma unroll
        for (int e = 0; e < NEXP; ++e) { const bool taken = (k > 0 && ti[0] == e) || (k > 1 && ti[1] == e) || (k > 2 && ti[2] == e); if (!taken && lg[e] > best) { best = lg[e]; bi = e; } }
        ti[k] = bi; tv[k] = best; }
    float ex[TOPK], es = 0.f;
#pragma unroll
    for (int k = 0; k < TOPK; ++k) { ex[k] = __expf(tv[k] - tv[0]); es += ex[k]; }
    if (lane < TOPK) {
        const int e = lane == 0 ? ti[0] : lane == 1 ? ti[1] : lane == 2 ? ti[2] : ti[3];
        const float w = (lane == 0 ? ex[0] : lane == 1 ? ex[1] : lane == 2 ? ex[2] : ex[3]) / es;
        const unsigned slot = atomicAdd(cnt + e, 1u);
        TOPI[row * TOPK + lane] = e; TOPW[row * TOPK + lane] = w; TOPS[row * TOPK + lane] = (int)slot;
        LIST[(size_t)e * NTOK + slot] = row;
    }
}
__device__ __forceinline__ void moe_combine_row(int row, float* X, const bf16_t* YD, const int* TOPI, const float* TOPW, const int* TOPS, const LAS int* tp, const float* gate,
                                                const float* lng, const float* lnb, const float* nshift, const float* nscale, bf16_t* Hn, float* out, int lane) {
    f32x4* xr = (f32x4*)(X + (size_t)row * DM) + lane;
    f32x4 y[4] = {};
#pragma unroll
    for (int k = 0; k < TOPK; ++k) { const int e = TOPI[row * TOPK + k]; const float w = TOPW[row * TOPK + k]; const size_t dr = (size_t)tp[e] * 256 + TOPS[row * TOPK + k];
        const u32x2* yp = (const u32x2*)(YD + dr * DM) + lane;
#pragma unroll
        for (int j = 0; j < 4; ++j) { const u32x2 q = yp[64 * j]; y[j][0] += w * bflo(q.x); y[j][1] += w * bfhi(q.x); y[j][2] += w * bflo(q.y); y[j][3] += w * bfhi(q.y); } }
    f32x4 v[4]; float s = 0.f;
#pragma unroll
    for (int j = 0; j < 4; ++j) { const f32x4 g = *(const f32x4*)(gate + 4 * lane + 256 * j); v[j] = xr[64 * j] * DN_ALPHA + g * y[j]; s += (v[j][0] + v[j][1]) + (v[j][2] + v[j][3]); }
    const float mean = wave_sum(s) * (1.f / DM); float s2 = 0.f;
#pragma unroll
    for (int j = 0; j < 4; ++j) { v[j] = v[j] - mean; s2 += (v[j][0] * v[j][0] + v[j][1] * v[j][1]) + (v[j][2] * v[j][2] + v[j][3] * v[j][3]); }
    const float rstd = 1.f / sqrtf(wave_sum(s2) * (1.f / DM) + LN_EPS);
#pragma unroll
    for (int j = 0; j < 4; ++j) { const int c = 4 * lane + 256 * j;
        const f32x4 g = *(const f32x4*)(lng + c), b = *(const f32x4*)(lnb + c);
        v[j] = v[j] * rstd * g + b; xr[64 * j] = v[j];
        if (Hn) { const f32x4 sh = *(const f32x4*)(nshift + c), sc = *(const f32x4*)(nscale + c); const f32x4 hh = v[j] * (sc + 1.0f) + sh;
            u32x2 w; w.x = cvt_pk_bf16(hh[0], hh[1]); w.y = cvt_pk_bf16(hh[2], hh[3]); *(u32x2*)(Hn + (size_t)row * DM + c) = w; }
        if (out && row >= CTX) *(f32x4*)(out + (size_t)(row - CTX) * DM + c) = v[j]; }
}
__device__ __forceinline__ void diff_combine_row(int row, const float* OA, bf16_t* OB, float lam, const float* subg, float post, int lane) {
    const int head = lane >> 3, d0 = (lane & 7) * 16;
    const float* p1 = OA + (size_t)row * 2048 + (2 * head) * 128 + d0; const float* p2 = p1 + 128;
    float o[16]; float q = 0.f;
#pragma unroll
    for (int j = 0; j < 4; ++j) { const f32x4 a = *(const f32x4*)(p1 + 4 * j), b = *(const f32x4*)(p2 + 4 * j);
#pragma unroll
        for (int e = 0; e < 4; ++e) { o[4 * j + e] = a[e] - lam * b[e]; q += o[4 * j + e] * o[4 * j + e]; } }
    q += __shfl_xor(q, 1); q += __shfl_xor(q, 2); q += __shfl_xor(q, 4);
    const float r = post / sqrtf(q * (1.f / 128.f) + LN_EPS);
    u32x4 w0, w1;
    const f32x4 g0 = *(const f32x4*)(subg + d0), g1 = *(const f32x4*)(subg + d0 + 4), g2 = *(const f32x4*)(subg + d0 + 8), g3 = *(const f32x4*)(subg + d0 + 12);
    w0.x = cvt_pk_bf16(o[0] * r * g0[0], o[1] * r * g0[1]); w0.y = cvt_pk_bf16(o[2] * r * g0[2], o[3] * r * g0[3]); w0.z = cvt_pk_bf16(o[4] * r * g1[0], o[5] * r * g1[1]); w0.w = cvt_pk_bf16(o[6] * r * g1[2], o[7] * r * g1[3]);
    w1.x = cvt_pk_bf16(o[8] * r * g2[0], o[9] * r * g2[1]); w1.y = cvt_pk_bf16(o[10] * r * g2[2], o[11] * r * g2[3]); w1.z = cvt_pk_bf16(o[12] * r * g3[0], o[13] * r * g3[1]); w1.w = cvt_pk_bf16(o[14] * r * g3[2], o[15] * r * g3[3]);
    bf16_t* op = OB + (size_t)row * DM + head * 128 + d0; *(u32x4*)op = w0; *(u32x4*)(op + 8) = w1;
}
__device__ __forceinline__ void transpose_item(const float* W, int K, int N, bf16_t* WT, int ldk, int mode, int roff, int koff, LAS float* scr, int item, int lane) {
    const int nblk = N / 32, kb = item / nblk, nb = item % nblk, k0 = 64 * kb, n0 = 32 * nb;
#pragma unroll 8
    for (int i = 0; i < 32; ++i) { const int kk = 2 * i + (lane >> 5); scr[kk * 33 + (lane & 31)] = W[(size_t)(k0 + kk) * N + n0 + (lane & 31)]; }
    asm volatile("s_waitcnt lgkmcnt(0)" ::: "memory");
    const int c = lane & 7;
    const int d0 = (mode == 1 || mode == 2) ? ((n0 >> 7) * 256 + (n0 & 127) + (mode == 2 ? 128 : 0)) : (roff + n0);
#pragma unroll
    for (int j = 0; j < 4; ++j) { const int n = (lane >> 3) + 8 * j; const LAS float* s = scr + (8 * c) * 33 + n;
        u32x4 o; o.x = cvt_pk_bf16(s[0 * 33], s[1 * 33]); o.y = cvt_pk_bf16(s[2 * 33], s[3 * 33]); o.z = cvt_pk_bf16(s[4 * 33], s[5 * 33]); o.w = cvt_pk_bf16(s[6 * 33], s[7 * 33]);
        *(u32x4*)(WT + (size_t)(d0 + n) * ldk + koff + k0 + 8 * c) = o; }
    asm volatile("s_waitcnt lgkmcnt(0)" ::: "memory");
}
__device__ __forceinline__ float silu_f(float v) { return v / (1.0f + __expf(-v)); }
__device__ __forceinline__ f32x2 cmul(f32x2 a, f32x2 b) { return (f32x2){a.x * b.x - a.y * b.y, a.x * b.y + a.y * b.x}; }
constexpr size_t MiB = 1u << 20;
constexpr size_t al1m(size_t x) { return (x + MiB - 1) / MiB * MiB; }
constexpr size_t WS_CTL = 0, CTL_ZERO_BYTES = 1 * MiB;
constexpr size_t WS_WFN = 1 * MiB;
constexpr size_t WS_WGU = 2 * MiB;
constexpr size_t WS_WD = WS_WGU + (size_t)4 * 32 * 2048 * 1024 * 2;
constexpr size_t WS_WIN = WS_WD + (size_t)4 * 32 * 1024 * 1024 * 2;
constexpr size_t WS_WGLU = WS_WIN + 4 * MiB;
constexpr size_t WS_WOUT = WS_WGLU + 1 * MiB;
constexpr size_t WS_WQKV = WS_WOUT + 4 * MiB;
constexpr size_t WS_WO = WS_WQKV + 12 * MiB;
constexpr size_t WS_MS = WS_WO + 4 * MiB;
constexpr size_t WS_KM = WS_MS + 16 * MiB;
constexpr size_t WS_POW = WS_KM + 48 * MiB;
constexpr size_t WS_BBAR = WS_POW + 3 * MiB;
constexpr size_t WS_APOW = WS_BBAR + 1 * MiB;
constexpr size_t WS_MOD = WS_APOW + 1 * MiB;
constexpr size_t WS_PART = WS_MOD + 1 * MiB;
constexpr size_t WS_ROPE = WS_PART + 3 * MiB;
constexpr size_t WS_RWT = WS_ROPE + 1 * MiB;
constexpr size_t WS_X = WS_RWT + 1 * MiB;
constexpr size_t WS_H = WS_X + al1m((size_t)NTOK * DM * 4);
constexpr size_t WS_H2 = WS_H + al1m((size_t)NTOK * DM * 2);
constexpr size_t WS_UP = WS_H2 + al1m((size_t)NTOK * DM * 2);
constexpr size_t WS_SLOC = WS_UP + al1m((size_t)S5G * NCHP * UPW * 2);
constexpr size_t WS_ZF = WS_SLOC + al1m((size_t)S5G * NCH * 256 * 4);
constexpr size_t WS_TT = WS_ZF + al1m((size_t)NTOK * 512 * 2);
constexpr size_t WS_SPEC = WS_TT + al1m((size_t)NTOK * 512 * 8);
constexpr size_t WS_YG = WS_SPEC + al1m((size_t)NTOK * 512 * 2);
constexpr size_t WS_CAT = WS_YG + al1m((size_t)NTOK * 512 * 2);
constexpr size_t WS_QKV = WS_CAT + al1m((size_t)NTOK * DM * 2);
constexpr size_t WS_OA = WS_QKV + al1m((size_t)NTOK * 3072 * 2);
constexpr size_t WS_OB = WS_OA + al1m((size_t)NTOK * 2048 * 4);
constexpr size_t WS_TOPI = WS_OB + al1m((size_t)NTOK * DM * 2);
constexpr size_t WS_TOPW = WS_TOPI + 1 * MiB;
constexpr size_t WS_TOPS = WS_TOPW + 1 * MiB;
constexpr size_t WS_LIST = WS_TOPS + 1 * MiB;
constexpr int MAXROWS = (NTOK * TOPK / 256 + NEXP) * 256;
constexpr size_t WS_ACT = WS_LIST + 3 * MiB;
constexpr size_t WS_YD = WS_ACT + al1m((size_t)MAXROWS * DM * 2);
constexpr size_t WS_END = WS_YD + al1m((size_t)MAXROWS * DM * 2);
static_assert(WS_END <= (size_t)2048 * MiB, "workspace map exceeds 2 GiB");
constexpr int CW_BAR = 4096;
constexpr int CW_CNT = 240000;
constexpr int NPHASE = 43;

constexpr int SCR_BYTES = 135168;
constexpr int LDS_TP = SCR_BYTES;
constexpr int LDS_CNT = SCR_BYTES + 160;
constexpr int LDS_MISC = SCR_BYTES + 320;
constexpr int LDS_BYTES = 147456;

#define XB_TMO      128
#define XB_XCNT(j)  (256  + 64 * (j))
#define XB_XSUB(j)  (1280 + 64 * (j))
#define XB_XGEN(j)  (2304 + 64 * (j))
#define XB_TOP      3328
#define XB_TOPGEN   3392
#define XCD_BAR_WORDS 3456
#define XB_SPIN_CAP (1u << 18)
__device__ __forceinline__ unsigned xb_ld(unsigned* p)              { return __hip_atomic_load(p, __ATOMIC_RELAXED, __HIP_MEMORY_SCOPE_AGENT); }
__device__ __forceinline__ unsigned xb_add(unsigned* p, unsigned v) { return __hip_atomic_fetch_add(p, v, __ATOMIC_RELAXED, __HIP_MEMORY_SCOPE_AGENT); }
__device__ __forceinline__ unsigned xb_xcc_id() { return (unsigned)__builtin_amdgcn_s_getreg((3 << 11) | 20) & 0xFu; }
#define XB_SPIN(cond, bar) do { unsigned _sp = 0; while (cond) { __builtin_amdgcn_s_sleep(1); \
    if ((++_sp & 255u) == 0u) { if (xb_ld(&(bar)[XB_TMO])) break; if (_sp > XB_SPIN_CAP) { atomicAdd(&(bar)[XB_TMO], 1u); break; } } } } while (0)
struct XcdBarrier { unsigned* bar; unsigned x; volatile LAS unsigned* st; };
__device__ __forceinline__ XcdBarrier xcd_barrier_post(unsigned* bar, volatile LAS unsigned* st) {
    XcdBarrier b; b.bar = bar; b.x = xb_xcc_id(); b.st = st;
    if (threadIdx.x == 0) (void)xb_add(&bar[XB_XCNT(b.x)], 1u);
    return b;
}
__device__ __forceinline__ void xcd_barrier_complete(unsigned* bar, unsigned x, unsigned& nloc, unsigned& nx) {
    const unsigned G = gridDim.x * gridDim.y * gridDim.z;
    unsigned sum, cnt, mine, sp = 0u;
    for (;;) {
        sum = 0u; cnt = 0u; mine = 0u;
#pragma unroll
        for (unsigned j = 0; j < 16; ++j) { const unsigned c = xb_ld(&bar[XB_XCNT(j)]); sum += c; cnt += (c > 0u) ? 1u : 0u; mine = (j == x) ? c : mine; }
        if (sum == G) break;
        __builtin_amdgcn_s_sleep(1);
        if ((++sp & 255u) == 0u) { if (xb_ld(&bar[XB_TMO])) break; if (sp > XB_SPIN_CAP) { atomicAdd(&bar[XB_TMO], 1u); break; } }
    }
    nloc = mine > 0u ? mine : 1u; nx = cnt > 0u ? cnt : 1u;
}
__device__ __forceinline__ void xcd_barrier(const XcdBarrier& b) {
    asm volatile("s_waitcnt vmcnt(0)" ::: "memory");
    __syncthreads();
    if (threadIdx.x == 0) {
        unsigned* bar = b.bar;
        __builtin_amdgcn_s_waitcnt(0);
        unsigned nloc = b.st[0], nx = b.st[1];
        if (nloc == 0u) { xcd_barrier_complete(bar, b.x, nloc, nx); b.st[0] = nloc; b.st[1] = nx; }
        const unsigned old = xb_add(&bar[XB_XSUB(b.x)], 1u);
        const unsigned gen = old / nloc;
        if (old + 1u == (gen + 1u) * nloc) {
            __builtin_amdgcn_fence(__ATOMIC_RELEASE, "agent");
            asm volatile("s_waitcnt vmcnt(0)" ::: "memory");
            const unsigned og = xb_add(&bar[XB_TOP], 1u);
            const unsigned tg = og / nx;
            if (og + 1u == (tg + 1u) * nx) xb_add(&bar[XB_TOPGEN], 1u);
            else XB_SPIN(xb_ld(&bar[XB_TOPGEN]) == tg, bar);
            __builtin_amdgcn_fence(__ATOMIC_ACQUIRE, "agent");
            xb_add(&bar[XB_XGEN(b.x)], 1u);
            asm volatile("s_waitcnt vmcnt(0)" ::: "memory");
        } else {
            XB_SPIN(xb_ld(&bar[XB_XGEN(b.x)]) == gen, bar);
            __builtin_amdgcn_fence(__ATOMIC_ACQUIRE, "agent");
            asm volatile("s_waitcnt vmcnt(0)" ::: "memory");
        }
    }
    __syncthreads();
}

#ifndef MK_SITES
#define MK_SITES 0xffffffffull
#endif
#define SITE(n) ((((unsigned long long)(MK_SITES)) >> (n)) & 1ull)
struct Args { const float* in[37]; float* out; unsigned char* ws; int ph_lo, ph_hi, li, pad; };
enum { I_X = 0, I_C, I_CTX, I_CCTX, I_ADAW, I_ADAB, I_LNG, I_LNB, I_WIN, I_LAMRE, I_LAMIM, I_LOGDT, I_BRE, I_BIM, I_CRE, I_CIM, I_S5D, I_WGLU, I_BGLU, I_FNW, I_FNB, I_WOUT,
       I_WQKV, I_WO, I_LQ1, I_LK1, I_LQ2, I_LK2, I_SUBG, I_RW, I_RB, I_WG, I_BG, I_WU, I_BU, I_WDN, I_BDN };

__device__ __forceinline__ void moe_tiles_to_lds(const unsigned* cntg, LAS int* tp, LAS int* cnt, int tid) {
    if (tid < 64) { int c = tid < NEXP ? (int)cntg[tid] : 0; if (tid < NEXP) cnt[tid] = c; int t = (c + 255) >> 8;
#pragma unroll
        for (int o = 1; o < 32; o <<= 1) { const int v = __shfl_up(t, o); if ((tid & 63) >= o) t += v; }
        if (tid < NEXP) tp[tid + 1] = t; if (tid == 0) tp[0] = 0; }
    __syncthreads();
}

#define WGU ((bf16_t*)(wsl + WS_WGU))
#define WD ((bf16_t*)(wsl + WS_WD))
#define WIN ((bf16_t*)(wsl + WS_WIN))
#define WGLU ((bf16_t*)(wsl + WS_WGLU))
#define WFN ((bf16_t*)(wsl + WS_WFN))
#define WOUT ((bf16_t*)(wsl + WS_WOUT))
#define WQKV ((bf16_t*)(wsl + WS_WQKV))
#define WO ((bf16_t*)(wsl + WS_WO))
#define MS ((bf16_t*)(wsl + WS_MS))
#define KM ((bf16_t*)(wsl + WS_KM))
#define POW ((f32x2*)(wsl + WS_POW))
#define BBAR ((f32x2*)(wsl + WS_BBAR))
#define APOW ((f32x2*)(wsl + WS_APOW))
#define MOD ((float*)(wsl + WS_MOD))
#define PART ((float*)(wsl + WS_PART))
#define ROPE ((float*)(wsl + WS_ROPE))
#define RWT ((float*)(wsl + WS_RWT))
#define X ((float*)(wsl + WS_X))
#define H ((bf16_t*)(wsl + WS_H))
#define H2 ((bf16_t*)(wsl + WS_H2))
#define UP ((bf16_t*)(wsl + WS_UP))
#define SLOC ((float*)(wsl + WS_SLOC))
#define ZF ((bf16_t*)(wsl + WS_ZF))
#define TT ((f32x2*)(wsl + WS_TT))
#define SPEC ((bf16_t*)(wsl + WS_SPEC))
#define YG ((bf16_t*)(wsl + WS_YG))
#define CAT ((bf16_t*)(wsl + WS_CAT))
#define QKV ((bf16_t*)(wsl + WS_QKV))
#define OA ((float*)(wsl + WS_OA))
#define OB ((bf16_t*)(wsl + WS_OB))
#define TOPI ((int*)(wsl + WS_TOPI))
#define TOPW ((float*)(wsl + WS_TOPW))
#define TOPS ((int*)(wsl + WS_TOPS))
#define LIST ((int*)(wsl + WS_LIST))
#define ACT ((bf16_t*)(wsl + WS_ACT))
#define YD ((bf16_t*)(wsl + WS_YD))
#define CTLW ((unsigned*)(wsl + WS_CTL))
#define PHASE_BEGIN unsigned char* wsl = args.ws; asm volatile("" : "+s"(wsl)); const float* const* in = args.in; \
    int tid = threadIdx.x; asm volatile("" : "+v"(tid)); const int lane = tid & 63, wave = __builtin_amdgcn_readfirstlane(tid >> 6), gw = bx * 8 + wave; (void)lane; (void)gw;
__global__ void __launch_bounds__(512, 2) mega(Args args) {
    extern __shared__ __attribute__((aligned(16))) unsigned char lds[];
    LAS unsigned char* ldsl = (LAS unsigned char*)lds;
    const int tid = threadIdx.x, lane = tid & 63, wave = __builtin_amdgcn_readfirstlane(tid >> 6);
    const int G = gridDim.x, bx = blockIdx.x;
    const int vcu = (G % 8 == 0) ? (bx % 8) * (G / 8) + bx / 8 : bx;
    const int gw = bx * 8 + wave, NGW = G * 8;
    unsigned char* ws = args.ws;
    unsigned* ctl = (unsigned*)(ws + WS_CTL);
    for (int u = tid; u < (LDS_BYTES - SCR_BYTES) / 4; u += 512) ((LAS unsigned*)(ldsl + SCR_BYTES))[u] = 0u;
    __syncthreads();
    volatile LAS unsigned* MISC = (volatile LAS unsigned*)(ldsl + LDS_MISC);
    LAS int* tp = (LAS int*)(ldsl + LDS_TP); LAS int* cntl = (LAS int*)(ldsl + LDS_CNT);
    XcdBarrier bar = xcd_barrier_post(ctl + CW_BAR + args.li * XCD_BAR_WORDS, MISC + 8);
    const int lo = args.ph_lo, hi = args.ph_hi;
#define IN(k) (lo <= (k) && (k) < hi)
#define SEAM(k) do { if (IN(k) && (k) + 1 < hi) xcd_barrier(bar); } while (0)


    if (SITE(0) && IN(0)) { PHASE_BEGIN
        LAS float* scr = (LAS float*)(ldsl + wave * 16384);
        constexpr int MOE_ITEMS = 384 * 512;
        constexpr int I_SM0 = MOE_ITEMS, I_SM1 = I_SM0 + 2 * 512  , I_SM2 = I_SM1 + 2 * 128  , I_SM3 = I_SM2 + 2 * 4 * 8  , I_SM4 = I_SM3 + 2 * 512  ,
                      I_SM5 = I_SM4 + 2 * 1536  , I_SM6 = I_SM5 + 2 * 512  ;
        for (int it = gw; it < I_SM6; it += NGW) {
            if (it < MOE_ITEMS) { const int m = it >> 9, r = it & 511;
                if (m < 128) transpose_item(in[I_WG] + (size_t)m * 1048576, 1024, 1024, WGU + (size_t)m * 2097152, 1024, 1, 0, 0, scr, r, lane);
                else if (m < 256) transpose_item(in[I_WU] + (size_t)(m - 128) * 1048576, 1024, 1024, WGU + (size_t)(m - 128) * 2097152, 1024, 2, 0, 0, scr, r, lane);
                else transpose_item(in[I_WDN] + (size_t)(m - 256) * 1048576, 1024, 1024, WD + (size_t)(m - 256) * 1048576, 1024, 0, 0, 0, scr, r, lane);
            } else if (it < I_SM1) { const int r = it - I_SM0, i = r >> 9; transpose_item(in[I_WIN] + (size_t)i * 1048576, 1024, 1024, WIN + (size_t)i * 1048576, 1024, 0, 0, 0, scr, r & 511, lane); }
            else if (it < I_SM2) { const int r = it - I_SM1, i = r >> 7; transpose_item(in[I_WGLU] + (size_t)i * 262144, 512, 512, WGLU + (size_t)i * 262144, 512, 0, 0, 0, scr, r & 127, lane); }
            else if (it < I_SM3) { const int r = it - I_SM2, ig = r >> 3, i = ig >> 2, g = ig & 3; transpose_item(in[I_FNW] + (size_t)ig * 16384, 128, 128, WFN + (size_t)i * 262144, 512, 3, g * 128, g * 128, scr, r & 7, lane); }
            else if (it < I_SM4) { const int r = it - I_SM3, i = r >> 9; transpose_item(in[I_WOUT] + (size_t)i * 1048576, 1024, 1024, WOUT + (size_t)i * 1048576, 1024, 0, 0, 0, scr, r & 511, lane); }
            else if (it < I_SM5) { const int r = it - I_SM4, i = r / 1536; transpose_item(in[I_WQKV] + (size_t)i * 3145728, 1024, 3072, WQKV + (size_t)i * 3145728, 1024, 0, 0, 0, scr, r % 1536, lane); }
            else { const int r = it - I_SM5, i = r >> 9; transpose_item(in[I_WO] + (size_t)i * 1048576, 1024, 1024, WO + (size_t)i * 1048576, 1024, 0, 0, 0, scr, r & 511, lane); }
        }
        for (int it = gw; it < 16 * 4 * 24; it += NGW) {
            const int nb = it % 24, l = (it / 24) & 3, kb = it / 96;
            const float al = silu_f(in[I_C][kb * 64 + lane]), ac = silu_f(in[I_CCTX][kb * 64 + lane]);
            const float* wp = in[I_ADAW] + ((size_t)l * 1024 + kb * 64) * 6144 + nb * 256 + 4 * lane;
            f32x4 sl = {0.f, 0.f, 0.f, 0.f}, sc = {0.f, 0.f, 0.f, 0.f};
#pragma unroll 8
            for (int kk = 0; kk < 64; ++kk) { const f32x4 w = *(const f32x4*)(wp + (size_t)kk * 6144); const float a = __shfl(al, kk), b = __shfl(ac, kk); sl += w * a; sc += w * b; }
            float* pp = PART + ((size_t)(kb * 4 + l) * 2) * 6144 + nb * 256 + 4 * lane;
            *(f32x4*)pp = sl; *(f32x4*)(pp + 6144) = sc;
        }
        for (int t = bx * 512 + tid; t < 8192; t += G * 512) {
            const int n = t & 63, g = (t >> 6) & 31, dir = (t >> 11) & 1, i = t >> 12;
            const int gi = (i * 2 + dir) * 32 + g;
            const double lre = (double)in[I_LAMRE][gi * 64 + n], lim = (double)in[I_LAMIM][gi * 64 + n], dt = exp((double)in[I_LOGDT][gi]);
            f32x2* pw = POW + (size_t)(gi * 64 + n) * 33;
            double br = 0, bi = 0;
            for (int k = 0; k <= 32; ++k) { const double mag = exp(k * dt * lre); double sn, cs; sincos(k * dt * lim, &sn, &cs); pw[k] = (f32x2){(float)(mag * cs), (float)(mag * sn)};
                if (k == 1) { br = mag * cs; bi = mag * sn; } if (k == 32) APOW[i * 4096 + (dir * 32 + g) * 64 + n] = (f32x2){(float)(mag * cs), (float)(mag * sn)}; }
            const double nr = br - 1.0, ni = bi, den = lre * lre + lim * lim; const double cr = (nr * lre + ni * lim) / den, ci = (ni * lre - nr * lim) / den;
            for (int c = 0; c < 16; ++c) { const double xr = (double)in[I_BRE][(size_t)(gi * 64 + n) * 16 + c], xi = (double)in[I_BIM][(size_t)(gi * 64 + n) * 16 + c];
                BBAR[(size_t)(gi * 64 + n) * 16 + c] = (f32x2){(float)(cr * xr - ci * xi), (float)(cr * xi + ci * xr)}; }
        }
        for (int t = bx * 512 + tid; t < 256 * 16; t += G * 512) { const int pos = t >> 4, f = t & 15; const double th = pow(10000.0, -(double)f / 16.0); double sn, cs; sincos((double)pos * th, &sn, &cs);
            ROPE[t * 2] = (float)cs; ROPE[t * 2 + 1] = (float)sn; }
        for (int t = bx * 512 + tid; t < 4 * 32768; t += G * 512) { const int l = t >> 15, r = t & 32767, c = r >> 5, e = r & 31; RWT[(size_t)l * 32768 + e * 1024 + c] = in[I_RW][t]; }
    }
    SEAM(0);
    if (SITE(1) && IN(1)) { PHASE_BEGIN
        for (int t = bx * 512 + tid; t < 4 * 2 * 6144; t += G * 512) { const int n = t % 6144, ls = t / 6144, l = ls >> 1; float s = in[I_ADAB][l * 6144 + n];
#pragma unroll
            for (int kb = 0; kb < 16; ++kb) s += PART[((size_t)kb * 8 + ls) * 6144 + n];
            MOD[t] = s; }
        float* KT = (float*)lds;
        for (int u = bx; u < 256; u += G) {
            const int q = u & 3, g = (u >> 2) & 31, i = u >> 7;
            for (int t = tid; t < 16384; t += 512) { const int cp = t & 15, c = (t >> 4) & 15, k = (t >> 8) & 31, dir = t >> 13; const int gi = (i * 2 + dir) * 32 + g;
                const float* cre = in[I_CRE] + ((size_t)gi * 16 + c) * 64; const float* cim = in[I_CIM] + ((size_t)gi * 16 + c) * 64; float s = 0.f;
                for (int n = 0; n < 64; ++n) { const f32x2 p = POW[(size_t)(gi * 64 + n) * 33 + k], b = BBAR[(size_t)(gi * 64 + n) * 16 + cp]; const f32x2 pb = cmul(p, b); s += cre[n] * pb.x - cim[n] * pb.y; }
                KT[t] = s; }
            __syncthreads();
            bf16_t* km = KM + ((size_t)(i * 32 + g) * 512 + q * 128) * 768;
            for (int t = tid; t < 128 * 768; t += 512) { const int col = t % 768, rr = t / 768, ii = q * 8 + (rr >> 4), c = rr & 15; float v;
                if (col < 512) { const int ip = col >> 4, cp = col & 15, k = ii - ip;
                    if (k > 0) v = KT[((0 * 32 + k) * 16 + c) * 16 + cp]; else if (k < 0) v = KT[((1 * 32 - k) * 16 + c) * 16 + cp];
                    else v = KT[(c) * 16 + cp] + KT[((32) * 16 + c) * 16 + cp] + (c == cp ? in[I_S5D][(i * 32 + g) * 16 + c] : 0.f);
                } else { const int comp = col - 512, dir = comp >> 7, im = (comp >> 6) & 1, n = comp & 63; const int gi = (i * 2 + dir) * 32 + g;
                    const f32x2 p = POW[(size_t)(gi * 64 + n) * 33 + (dir == 0 ? ii + 1 : 32 - ii)]; const float cr = in[I_CRE][((size_t)gi * 16 + c) * 64 + n], ci = in[I_CIM][((size_t)gi * 16 + c) * 64 + n];
                    v = im ? -(cr * p.y + ci * p.x) : (cr * p.x - ci * p.y); }
                km[t] = (bf16_t)(cvt_pk_bf16(v, 0.f) & 0xffffu); }
            bf16_t* ms = MS + ((size_t)(i * 32 + g) * 256 + q * 64) * 512;
            { const int dir = q >> 1, im = q & 1; const int gi = (i * 2 + dir) * 32 + g;
              for (int t = tid; t < 64 * 512; t += 512) { const int col = t & 511, n = t >> 9, ip = col >> 4, cp = col & 15;
                const f32x2 p = POW[(size_t)(gi * 64 + n) * 33 + (dir == 0 ? 31 - ip : ip)], b = BBAR[(size_t)(gi * 64 + n) * 16 + cp]; const f32x2 pb = cmul(p, b);
                ms[t] = (bf16_t)(cvt_pk_bf16(im ? pb.y : pb.x, 0.f) & 0xffffu); } }
            __syncthreads();
        }
    }
    SEAM(1);
    if (SITE(2) && IN(2)) { PHASE_BEGIN
        for (int row = gw; row < NTOK; row += NGW) {
            const float* src = row < CTX ? in[I_CTX] + (size_t)row * DM : in[I_X] + (size_t)(row - CTX) * DM; const float* md = MOD + (row < CTX ? 6144 : 0);
#pragma unroll
            for (int j = 0; j < 4; ++j) { const int c = 4 * lane + 256 * j; const f32x4 v = *(const f32x4*)(src + c), sh = *(const f32x4*)(md + c), sc = *(const f32x4*)(md + 1024 + c);
                *(f32x4*)(X + (size_t)row * DM + c) = v; const f32x4 hh = v * (sc + 1.0f) + sh; u32x2 w; w.x = cvt_pk_bf16(hh[0], hh[1]); w.y = cvt_pk_bf16(hh[2], hh[3]); *(u32x2*)(H + (size_t)row * DM + c) = w; } }
    }
    SEAM(2);

#pragma unroll 1
    for (int l = 0; l < 4; ++l) {
        const int pb = 3 + 10 * l, i = l >> 1;
#define modl (MOD + (size_t)l * 2 * 6144)
        if ((l & 1) == 0) {
            if (SITE(3) && IN(pb + 0)) { PHASE_BEGIN pg8::DenseSched S; S.init(H, DM, WIN + (size_t)i * 1048576, DM, NTOK, 1024, 1024, G, bx); pg8::EpiZ E{UP, ZF}; pg8::gemm_phase<pg8::EpiZ, pg8::DenseSched>(ldsl, S, E); }
            SEAM(pb + 0);
            if (SITE(4) && IN(pb + 1)) { PHASE_BEGIN
                f32x2* T = (f32x2*)lds; f32x2* tw = (f32x2*)(lds + 132096);
                if (tid < 64) { float sn, cs; sincospif(-(float)tid * (1.0f / 64.0f), &sn, &cs); tw[tid] = (f32x2){cs, sn}; }
                __syncthreads();
                for (int u = bx; u < 520; u += G) {
                    if (u < 512) { const int l2 = u >> 2, g = u & 3; fft_a_unit(ZF, TT, CTX + l2, 128, g, (float)l2 * (1.0f / 16384.0f), 6.905339660024878e-4f  , T, tw, tid); }
                    else { const int l2 = (u - 512) >> 2, g = u & 3; fft_a_unit(ZF, TT, l2, 2, g, (float)l2 * (1.0f / 256.0f), 5.5242717280199e-3f  , T, tw, tid); }
                }
                __syncthreads();
                pg8::BatchSched S; S.init(UP, (size_t)NCHP * UPW, UPW, MS + (size_t)i * 32 * 256 * 512, (size_t)256 * 512, 512, 3, 1, 32, 512, G, G - 1 - bx);
                pg8::EpiG1 E{SLOC}; pg8::gemm_phase<pg8::EpiG1, pg8::BatchSched>(ldsl, S, E);
            }
            SEAM(pb + 1);
            if (SITE(5) && IN(pb + 2)) { PHASE_BEGIN
                if (bx < 8 && G > 16) s5_scan_thread(bx * 512 + tid, SLOC, APOW + i * 4096, UP);
                else {
                    if (G <= 16) { for (int t = bx * 512 + tid; t < 4096; t += G * 512) s5_scan_thread(t, SLOC, APOW + i * 4096, UP); }
                    f32x2* T = (f32x2*)lds; f32x2* tw = (f32x2*)(lds + 132096);
                    if (tid < 64) { float sn, cs; sincospif(-(float)tid * (1.0f / 64.0f), &sn, &cs); tw[tid] = (f32x2){cs, sn}; }
                    __syncthreads();
                    const int nb = G > 16 ? G - 8 : G, b0 = G > 16 ? bx - 8 : bx;
                    for (int u = b0; u < 516; u += nb) {
                        if (u < 512) { const int k1 = u >> 2, g = u & 3; fft_b_unit(TT, SPEC, CTX + 128 * k1, CTX + k1, g, T, tw, tid); }
                        else { const int g = u - 512;
                            for (int p = tid; p < 2048; p += 512) { const int k1 = p >> 4, kc = (p & 15) * 8; const f32x2* a = TT + (size_t)(2 * k1) * 512 + g * 128 + kc; const f32x2* b = a + 512;
                                u32x4 w0, w1; float s[8], d[8];
#pragma unroll
                                for (int e = 0; e < 8; ++e) { s[e] = a[e].x + b[e].x; d[e] = a[e].x - b[e].x; }
                                w0.x = cvt_pk_bf16(s[0], s[1]); w0.y = cvt_pk_bf16(s[2], s[3]); w0.z = cvt_pk_bf16(s[4], s[5]); w0.w = cvt_pk_bf16(s[6], s[7]);
                                w1.x = cvt_pk_bf16(d[0], d[1]); w1.y = cvt_pk_bf16(d[2], d[3]); w1.z = cvt_pk_bf16(d[4], d[5]); w1.w = cvt_pk_bf16(d[6], d[7]);
                                *(u32x4*)(SPEC + (size_t)k1 * 512 + g * 128 + kc) = w0; *(u32x4*)(SPEC + (size_t)(k1 + 128) * 512 + g * 128 + kc) = w1; } }
                    }
                }
            }
            SEAM(pb + 2);
            if (SITE(6) && IN(pb + 3)) { PHASE_BEGIN
                { pg8::BatchSched S; S.init(UP, (size_t)NCHP * UPW, UPW, KM + (size_t)i * 32 * 512 * 768, (size_t)512 * 768, 768, 3, 2, 32, 768, G, bx);
                  pg8::EpiG2 E{YG}; pg8::gemm_phase<pg8::EpiG2, pg8::BatchSched>(ldsl, S, E); }
                { pg8::DenseSched S; S.init(SPEC, 512, WFN + (size_t)i * 262144, 512, NTOK, 512, 512, G, G - 1 - bx);
                  pg8::EpiBias16 E{CAT, 1024, 512, in[I_FNB] + i * 512, 0}; pg8::gemm_phase<pg8::EpiBias16, pg8::DenseSched>(ldsl, S, E); }
            }
            SEAM(pb + 3);
            if (SITE(7) && IN(pb + 4)) { PHASE_BEGIN pg8::DenseSched S; S.init(YG, 512, WGLU + (size_t)i * 262144, 512, NTOK, 512, 512, G, bx);
                pg8::EpiGLU E{YG, CAT, in[I_BGLU] + i * 512}; pg8::gemm_phase<pg8::EpiGLU, pg8::DenseSched>(ldsl, S, E); }
            SEAM(pb + 4);
            if (SITE(8) && IN(pb + 5)) { PHASE_BEGIN pg8::DenseSched S; S.init(CAT, DM, WOUT + (size_t)i * 1048576, DM, NTOK, 1024, 1024, G, bx);
                pg8::EpiRes E{X, modl + 2 * 1024, modl + 6144 + 2 * 1024}; pg8::gemm_phase<pg8::EpiRes, pg8::DenseSched>(ldsl, S, E); }
            SEAM(pb + 5);
        } else {
            if (SITE(9) && IN(pb + 0)) { PHASE_BEGIN pg8::DenseSched S; S.init(H, DM, WQKV + (size_t)i * 3145728, DM, NTOK, 3072, 1024, G, bx);
                pg8::EpiQKV E{QKV, ROPE}; pg8::gemm_phase<pg8::EpiQKV, pg8::DenseSched>(ldsl, S, E); }
            SEAM(pb + 0);
            if (SITE(10) && IN(pb + 1)) { PHASE_BEGIN
                const int xcd = vcu / (G / 8 > 0 ? G / 8 : 1), loc = vcu % (G / 8 > 0 ? G / 8 : 1), per = G / 8;
                if (G % 8 == 0 && per >= 1) {
                    for (int uu = loc; uu < 130; uu += per) {
                        int hm, row0, seq;
                        if (uu < 128) { hm = 2 * xcd + (uu >> 6); row0 = CTX + (uu & 63) * 256; seq = NTOK; } else { hm = 2 * xcd + (uu - 128); row0 = 0; seq = CTX; }
                        attn::attn_unit(QKV + (size_t)row0 * 3072 + hm * 64, QKV + 1024 + hm * 64, QKV + 2048 + (hm >> 1) * 128, OA + (size_t)row0 * 2048 + hm * 128, 2048, seq, (char*)lds, tid);
                    }
                } else {
                    for (int uu = bx; uu < 1040; uu += G) { int hm, row0, seq;
                        if (uu < 1024) { hm = uu >> 6; row0 = CTX + (uu & 63) * 256; seq = NTOK; } else { hm = uu - 1024; row0 = 0; seq = CTX; }
                        attn::attn_unit(QKV + (size_t)row0 * 3072 + hm * 64, QKV + 1024 + hm * 64, QKV + 2048 + (hm >> 1) * 128, OA + (size_t)row0 * 2048 + hm * 128, 2048, seq, (char*)lds, tid); }
                }
            }
            SEAM(pb + 1);
            if (SITE(11) && IN(pb + 2)) { PHASE_BEGIN
                const float d1 = wave_sum(in[I_LQ1][i * 64 + lane] * in[I_LK1][i * 64 + lane]), d2 = wave_sum(in[I_LQ2][i * 64 + lane] * in[I_LK2][i * 64 + lane]);
                const float lam_init = 0.8f - 0.6f * expf(-0.3f * (float)l), lam = expf(d1) - expf(d2) + lam_init;
                for (int row = gw; row < NTOK; row += NGW) diff_combine_row(row, OA, OB, lam, in[I_SUBG] + i * 128, 1.0f - lam_init, lane);
            }
            SEAM(pb + 2);
            if (SITE(12) && IN(pb + 3)) { PHASE_BEGIN pg8::DenseSched S; S.init(OB, DM, WO + (size_t)i * 1048576, DM, NTOK, 1024, 1024, G, bx);
                pg8::EpiRes E{X, modl + 2 * 1024, modl + 6144 + 2 * 1024}; pg8::gemm_phase<pg8::EpiRes, pg8::DenseSched>(ldsl, S, E); }
            SEAM(pb + 3);
        }
        if (SITE(13) && IN(pb + 6)) { PHASE_BEGIN
            float* wr = (float*)lds;
            for (int t = tid; t < 32768 / 4; t += 512) ((f32x4*)wr)[t] = ((const f32x4*)(RWT + (size_t)l * 32768))[t];
            __syncthreads();
            for (int row = gw; row < NTOK; row += NGW) { const float* md = modl + (row < CTX ? 6144 : 0);
                ln_router_row(row, X, H2, in[I_LNG] + (l * 2) * 1024, in[I_LNB] + (l * 2) * 1024, md + 3 * 1024, md + 4 * 1024, wr, in[I_RB] + l * 32, TOPI, TOPW, TOPS, LIST, CTLW + CW_CNT + l * 32, lane); }
            __syncthreads();
        }
        SEAM(pb + 6);
        if (SITE(14) && IN(pb + 7)) { PHASE_BEGIN
            moe_tiles_to_lds(CTLW + CW_CNT + l * 32, tp, cntl, tid);
            pg8::MoeSched<true> S{H2, WGU + (size_t)l * 32 * 2097152, (size_t)2097152, 1024, DM, DM, 8, G, bx, tp, cntl, LIST};
            pg8::EpiSwiGLU E{ACT, in[I_BG] + (size_t)l * 32768, in[I_BU] + (size_t)l * 32768}; pg8::gemm_phase<pg8::EpiSwiGLU, pg8::MoeSched<true>>(ldsl, S, E);
        }
        SEAM(pb + 7);
        if (SITE(15) && IN(pb + 8)) { PHASE_BEGIN
            moe_tiles_to_lds(CTLW + CW_CNT + l * 32, tp, cntl, tid);
            pg8::MoeSched<false> S{ACT, WD + (size_t)l * 32 * 1048576, (size_t)1048576, 1024, DM, DM, 4, G, bx, tp, cntl, LIST};
            pg8::EpiBias16 E{YD, 1024, 0, in[I_BDN] + (size_t)l * 32768, 1024}; pg8::gemm_phase<pg8::EpiBias16, pg8::MoeSched<false>>(ldsl, S, E);
        }
        SEAM(pb + 8);
        if (SITE(16) && IN(pb + 9)) { PHASE_BEGIN
            moe_tiles_to_lds(CTLW + CW_CNT + l * 32, tp, cntl, tid);
            for (int row = gw; row < NTOK; row += NGW) { const int s = row < CTX ? 1 : 0; const float* md = modl + s * 6144; const float* nmd = MOD + ((size_t)(l + 1) * 2 + s) * 6144;
                moe_combine_row(row, X, YD, TOPI, TOPW, TOPS, tp, md + 5 * 1024, in[I_LNG] + (l * 2 + 1) * 1024, in[I_LNB] + (l * 2 + 1) * 1024, nmd, nmd + 1024, l < 3 ? H : nullptr, l == 3 ? args.out : nullptr, lane); }
        }
        SEAM(pb + 9);
    }
#undef IN
#undef SEAM
}
#undef WGU
#undef WD
#undef WIN
#undef WGLU
#undef WFN
#undef WOUT
#undef WQKV
#undef WO
#undef MS
#undef KM
#undef POW
#undef BBAR
#undef APOW
#undef MOD
#undef PART
#undef ROPE
#undef RWT
#undef X
#undef H
#undef H2
#undef UP
#undef SLOC
#undef ZF
#undef TT
#undef SPEC
#undef YG
#undef CAT
#undef QKV
#undef OA
#undef OB
#undef TOPI
#undef TOPW
#undef TOPS
#undef LIST
#undef ACT
#undef YD
#undef CTLW
#undef PHASE_BEGIN
#undef modl


#ifndef MK_MULTI
#define MK_MULTI 1
#endif
extern "C" void kernel_launch(void* const* d_in, const int* in_sizes, int n_in, void* d_out, int out_size, void* d_ws, size_t ws_size, hipStream_t stream) {
    static int grid = 0;
    if (grid == 0) {
        if (n_in != 37 || out_size != SEQ * DM || ws_size < WS_END) { fprintf(stderr, "kernel_launch: unexpected shapes: n_in %d out %d ws %zu (need %zu)\n", n_in, out_size, ws_size, (size_t)WS_END); grid = -1; return; }
        int dev = 0, cus = 0, per_cu = 0;
        if (hipGetDevice(&dev) != hipSuccess || hipDeviceGetAttribute(&cus, hipDeviceAttributeMultiprocessorCount, dev) != hipSuccess) { grid = -1; return; }
        if (hipFuncSetAttribute((const void*)mega, hipFuncAttributeMaxDynamicSharedMemorySize, LDS_BYTES) != hipSuccess) { fprintf(stderr, "kernel_launch: hipFuncSetAttribute failed\n"); grid = -1; return; }
        if (hipOccupancyMaxActiveBlocksPerMultiprocessor(&per_cu, (const void*)mega, 512, LDS_BYTES) != hipSuccess || per_cu < 1) { fprintf(stderr, "kernel_launch: occupancy query reports %d blocks per CU\n", per_cu); }
        (void)hipGetLastError();
        grid = cus;
    }
    if (grid < 0) return;
    (void)hipMemsetAsync((char*)d_ws + WS_CTL, 0, 2 * MiB, stream);
    Args a{};
    for (int i = 0; i < 37; ++i) a.in[i] = (const float*)d_in[i];
    a.out = (float*)d_out; a.ws = (unsigned char*)d_ws;
#if MK_MULTI
    int li = 0;
    for (int ph = 0; ph < NPHASE; ++ph) {
        if (ph >= 3) { const int l = (ph - 3) / 10, s = (ph - 3) % 10; if ((l & 1) && (s == 4 || s == 5)) continue; }
        a.ph_lo = ph; a.ph_hi = ph + 1; a.li = li++;
        hipLaunchKernelGGL(mega, dim3(grid), dim3(512), LDS_BYTES, stream, a);
    }
#else
    a.ph_lo = 0; a.ph_hi = NPHASE; a.li = 0;
    hipLaunchKernelGGL(mega, dim3(grid), dim3(512), LDS_BYTES, stream, a);
#endif
    const hipError_t le = hipPeekAtLastError();
    if (le != hipSuccess) fprintf(stderr, "kernel_launch: launch failed: %s\n", hipGetErrorName(le));
}
```

```cpp
#include <hip/hip_runtime.h>
#include <cstdio>
#include <cstdint>

#define LAS __attribute__((address_space(3)))
#define GAS __attribute__((address_space(1)))
typedef unsigned short bf16_t;
typedef short bf16x8 __attribute__((ext_vector_type(8)));
typedef short s16x4 __attribute__((ext_vector_type(4)));
typedef float f32x4 __attribute__((ext_vector_type(4)));
typedef float f32x2 __attribute__((ext_vector_type(2)));
typedef float f32x16 __attribute__((ext_vector_type(16)));
typedef unsigned u32x4 __attribute__((ext_vector_type(4)));
typedef unsigned u32x2 __attribute__((ext_vector_type(2)));

constexpr int DM = 1024, SEQ = 16384, CTX = 256, NTOK = SEQ + CTX;
constexpr int NEXP = 32, TOPK = 4;
constexpr int S5G = 32, S5C = 16, S5N = 64, CHT = 32, NCH = NTOK / CHT  , NCH_CTX = CTX / CHT  , NCHP = 768;
constexpr int UPW = 768;
constexpr float LN_EPS = 1e-5f;
constexpr float DN_ALPHA = 1.681792830507429f;

__device__ __forceinline__ unsigned cvt_pk_bf16(float lo, float hi) { unsigned r; asm volatile("v_cvt_pk_bf16_f32 %0, %1, %2" : "=v"(r) : "v"(lo), "v"(hi)); return r; }
__device__ __forceinline__ float bf2f(unsigned short b) { return __uint_as_float(((unsigned)b) << 16); }
__device__ __forceinline__ float bflo(unsigned w) { return __uint_as_float(w << 16); }
__device__ __forceinline__ float bfhi(unsigned w) { return __uint_as_float(w & 0xffff0000u); }
__device__ __forceinline__ float fast_sigmoid(float x) { return __builtin_amdgcn_rcpf(1.0f + __builtin_amdgcn_exp2f(-1.4426950408889634f * x)); }

namespace pg8 {
constexpr int BM = 256, BK = 64, HALF = 128, HTB = HALF * BK * 2, STAGE_BYTES = 8 * HTB;
__host__ __device__ __forceinline__ int lds_byte(int r, int c) { const int st = (r >> 4) * 2 + (c >> 5), rr = r & 15, cc = c & 31, ob = rr * 64 + cc * 2; return st * 1024 + (ob ^ (((ob >> 9) & 1) << 5)); }
__host__ __device__ __forceinline__ void stage_rc(int b, int& R, int& C) { const int st = b / 1024, sb = b % 1024, swz = sb ^ (((sb >> 9) & 1) << 5); R = (st >> 1) * 16 + swz / 64; C = (st & 1) * 32 + (swz % 64) / 2; }
__host__ __device__ __forceinline__ int perm32(int rho) { const int n = rho >> 4, i = rho & 15; return 8 * (i >> 2) + 4 * n + (i & 3); }

struct Unit { int pm, pn, z, aux; };

template <class Epi, class Sched>
__device__ __forceinline__ void gemm_phase(LAS unsigned char* lds, const Sched& S, const Epi& E) {
    int tid_ = threadIdx.x; asm volatile("" : "+v"(tid_));
    const int tid = tid_, wid = __builtin_amdgcn_readfirstlane(tid >> 6), lane = tid & 63, wr = wid >> 2, wc = wid & 3, fr = lane & 15, fq = lane >> 4;
    const int K = S.K, nt = K / BK, ldb = S.ldb;
    constexpr bool GA = Sched::GATHER;
    int Rr[2], Cc[2]; unsigned voffB[2];
#pragma unroll
    for (int i = 0; i < 2; ++i) { int R, C; stage_rc(tid * 16 + i * 8192, R, C); Rr[i] = R; Cc[i] = C * 2; const int Rb = Epi::PERM ? ((R & ~31) + perm32(R & 31)) : R; voffB[i] = (unsigned)(Rb * ldb + C) * 2u; }
    const size_t kstep = (size_t)(BK * 2);
    const size_t hstepB = (size_t)HALF * ldb * 2;
    const unsigned ldsw = (unsigned)wid * 1024u;
    const int aoff = lds_byte(wr * 64 + fr, fq * 8), boff = lds_byte(wc * 32 + fr, fq * 8);
#define PG8_SA(b, h) (((b) * 2 + (h)) * HTB)
#define PG8_SB(b, h) ((4 + (b) * 2 + (h)) * HTB)
#define PG8_STAGEB(bufoff, gbase) do { _Pragma("unroll") for (int _i = 0; _i < 2; ++_i) \
        __builtin_amdgcn_global_load_lds((const unsigned*)((const char*)(gbase) + voffB[_i]), (LAS unsigned*)(lds + (bufoff) + ldsw + _i * 8192), 16, 0, 0); } while (0)
#define PG8_STAGEA(bufoff, gbase, ro) do { _Pragma("unroll") for (int _i = 0; _i < 2; ++_i) \
        __builtin_amdgcn_global_load_lds((const unsigned*)((const char*)(gbase) + (ro)[_i]), (LAS unsigned*)(lds + (bufoff) + ldsw + _i * 8192), 16, 0, 0); } while (0)
#define PG8_LDA(dst, b, h) do { _Pragma("unroll") for (int m = 0; m < 4; ++m) _Pragma("unroll") for (int k = 0; k < 2; ++k) dst[m][k] = *(const LAS bf16x8*)(lds + PG8_SA(b, h) + aoff + m * 2048 + k * 1024); } while (0)
#define PG8_LDB(dst, b, h) do { _Pragma("unroll") for (int n = 0; n < 2; ++n) _Pragma("unroll") for (int k = 0; k < 2; ++k) dst[n][k] = *(const LAS bf16x8*)(lds + PG8_SB(b, h) + boff + n * 2048 + k * 1024); } while (0)
#define PG8_MMA(ai, bj, At, Bt) do { __builtin_amdgcn_s_setprio(1); _Pragma("unroll") for (int m = 0; m < 4; ++m) _Pragma("unroll") for (int n = 0; n < 2; ++n) _Pragma("unroll") for (int k = 0; k < 2; ++k) \
        acc[ai][bj][m][n] = __builtin_amdgcn_mfma_f32_16x16x32_bf16(Bt[n][k], At[m][k], acc[ai][bj][m][n], 0, 0, 0); __builtin_amdgcn_s_setprio(0); } while (0)
#define PG8_WAIT_V(n) asm volatile("s_waitcnt vmcnt(" #n ")" ::: "memory")
#define PG8_WAIT_L(n) asm volatile("s_waitcnt lgkmcnt(" #n ")" ::: "memory")
#define PG8_BAR __builtin_amdgcn_s_barrier()
#define PG8_SCHED __builtin_amdgcn_sched_barrier(0)
    Unit cur, nxt; int ui = 0;
    if (!S.next(0, cur)) return;
    f32x4 acc[2][2][4][2];
#pragma unroll
    for (int a = 0; a < 2; ++a)
#pragma unroll
        for (int b = 0; b < 2; ++b)
#pragma unroll
            for (int m = 0; m < 4; ++m)
#pragma unroll
                for (int n = 0; n < 2; ++n) acc[a][b][m][n] = (f32x4){0.f, 0.f, 0.f, 0.f};
    bf16x8 At[4][2], B0[2][2], B1[2][2];
    unsigned ar0[2], ar1[2], nr0[2], nr1[2];
#pragma unroll
    for (int i = 0; i < 2; ++i) { ar0[i] = S.a_row(cur, Rr[i]) + (unsigned)Cc[i]; ar1[i] = S.a_row(cur, HALF + Rr[i]) + (unsigned)Cc[i]; nr0[i] = ar0[i]; nr1[i] = ar1[i]; }
    const char* cA = S.a_base(cur); const char* cB = S.b_base(cur);
    PG8_WAIT_V(0);
    PG8_STAGEB(PG8_SB(0, 0), cB); PG8_STAGEB(PG8_SB(0, 1), cB + hstepB); PG8_STAGEA(PG8_SA(0, 0), cA, ar0); PG8_STAGEA(PG8_SA(0, 1), cA, ar1);
    if (wr == 1) PG8_BAR;
    PG8_WAIT_V(2); PG8_BAR;
    PG8_STAGEB(PG8_SB(1, 0), cB + kstep); PG8_STAGEA(PG8_SA(1, 0), cA + kstep, ar0); PG8_STAGEB(PG8_SB(1, 1), cB + hstepB + kstep);
    PG8_WAIT_V(6); PG8_BAR;
    for (;;) {
        const bool has_next = S.next(ui + 1, nxt);
        const char* nA = has_next ? S.a_base(nxt) : cA; const char* nB = has_next ? S.b_base(nxt) : cB;
        if constexpr (GA) {
#pragma unroll
        for (int i = 0; i < 2; ++i) { nr0[i] = has_next ? S.a_row(nxt, Rr[i]) + (unsigned)Cc[i] : ar0[i]; nr1[i] = has_next ? S.a_row(nxt, HALF + Rr[i]) + (unsigned)Cc[i] : ar1[i]; }
        }
        for (int t = 0; t < nt; t += 2) {
            const bool last = (t == nt - 2);
            const char* a1 = cA + (size_t)(t + 1) * kstep;
            const char* a2 = last ? nA : cA + (size_t)(t + 2) * kstep; const char* b2 = last ? nB : cB + (size_t)(t + 2) * kstep;
            const char* a3 = a2 + kstep; const char* b3 = b2 + kstep;
            unsigned s0[2], s1[2];
#pragma unroll
            for (int i = 0; i < 2; ++i) { s0[i] = (GA && last) ? nr0[i] : ar0[i]; s1[i] = (GA && last) ? nr1[i] : ar1[i]; }
            PG8_LDB(B0, 0, 0); PG8_LDB(B1, 0, 1); PG8_SCHED; PG8_LDA(At, 0, 0); PG8_STAGEA(PG8_SA(1, 1), a1, ar1);
            PG8_WAIT_V(8); PG8_WAIT_L(0); PG8_BAR; PG8_MMA(0, 0, At, B0); PG8_MMA(0, 1, At, B1); PG8_BAR; PG8_SCHED;
            PG8_LDA(At, 0, 1); PG8_STAGEB(PG8_SB(0, 0), b2); PG8_STAGEB(PG8_SB(0, 1), b2 + hstepB); PG8_STAGEA(PG8_SA(0, 0), a2, s0);
            PG8_WAIT_V(8); PG8_WAIT_L(0); PG8_BAR; PG8_MMA(1, 0, At, B0); PG8_MMA(1, 1, At, B1); PG8_BAR; PG8_SCHED;
            PG8_LDB(B0, 1, 0); PG8_LDB(B1, 1, 1); PG8_SCHED; PG8_LDA(At, 1, 0); PG8_STAGEA(PG8_SA(0, 1), a2, s1);
            PG8_WAIT_V(8); PG8_WAIT_L(0); PG8_BAR; PG8_MMA(0, 0, At, B0); PG8_MMA(0, 1, At, B1); PG8_BAR; PG8_SCHED;
            PG8_LDA(At, 1, 1); PG8_STAGEB(PG8_SB(1, 0), b3); PG8_STAGEB(PG8_SB(1, 1), b3 + hstepB); PG8_STAGEA(PG8_SA(1, 0), a3, s0);
            PG8_WAIT_V(8); PG8_WAIT_L(0); PG8_BAR; PG8_MMA(1, 0, At, B0); PG8_MMA(1, 1, At, B1); PG8_BAR; PG8_SCHED;
        }
        if (wr == 0) PG8_BAR;
        E(acc, cur, wr, wc, fr, fq);
        if (!has_next) break;
#pragma unroll
        for (int a = 0; a < 2; ++a)
#pragma unroll
            for (int b = 0; b < 2; ++b)
#pragma unroll
                for (int m = 0; m < 4; ++m)
#pragma unroll
                    for (int n = 0; n < 2; ++n) acc[a][b][m][n] = (f32x4){0.f, 0.f, 0.f, 0.f};
        cur = nxt; cA = nA; cB = nB; ++ui;
        if constexpr (GA) {
#pragma unroll
        for (int i = 0; i < 2; ++i) { ar0[i] = nr0[i]; ar1[i] = nr1[i]; }
        }
        if (wr == 1) PG8_BAR;
    }
    PG8_WAIT_V(0);
    PG8_BAR;
#undef PG8_SA
#undef PG8_SB
#undef PG8_STAGEA
#undef PG8_STAGEB
#undef PG8_LDA
#undef PG8_LDB
#undef PG8_MMA
#undef PG8_WAIT_V
#undef PG8_WAIT_L
#undef PG8_BAR
#undef PG8_SCHED
}
}
namespace pg8 {
struct DenseSched {
    static constexpr bool GATHER = false;
    const bf16_t* A; const bf16_t* Bt; int K, lda, ldb;
    int nM, nN, nwg, G, c;
    __device__ __forceinline__ void init(const bf16_t* A_, int lda_, const bf16_t* Bt_, int ldb_, int M, int N, int K_, int G_, int c_) {
        A = A_; Bt = Bt_; K = K_; lda = lda_; ldb = ldb_; nM = M / BM; nN = N / BM; nwg = nM * nN; G = G_; c = c_; }
    __device__ __forceinline__ bool next(int i, Unit& u) const {
        const long L = (long)i * G + c; if (L >= nwg) return false;
        int wgid = (int)L; { const int q = nwg / 8, r = nwg % 8, xcd = wgid % 8, off = wgid / 8; wgid = (xcd < r ? xcd * (q + 1) : r * (q + 1) + (xcd - r) * q) + off; }
        const int nig = 8 * nN, gid = wgid / nig, fm = gid * 8, gsz = (nM - fm) < 8 ? (nM - fm) : 8;
        u.pm = fm + ((wgid % nig) % gsz); u.pn = (wgid % nig) / gsz; u.z = 0; u.aux = 0; return true;
    }
    __device__ __forceinline__ const char* a_base(const Unit& u) const { return (const char*)A + (size_t)u.pm * BM * lda * 2; }
    __device__ __forceinline__ unsigned a_row(const Unit&, int r) const { return (unsigned)r * (unsigned)lda * 2u; }
    __device__ __forceinline__ const char* b_base(const Unit& u) const { return (const char*)Bt + (size_t)u.pn * BM * ldb * 2; }
};
struct BatchSched {
    static constexpr bool GATHER = false;
    const bf16_t* A; const bf16_t* Bt; size_t sA, sB; int K, lda, ldb;
    int nM, nN, nZ, G, c;
    __device__ __forceinline__ void init(const bf16_t* A_, size_t sA_, int lda_, const bf16_t* Bt_, size_t sB_, int ldb_, int nM_, int nN_, int nZ_, int K_, int G_, int c_) {
        A = A_; Bt = Bt_; sA = sA_; sB = sB_; K = K_; lda = lda_; ldb = ldb_; nM = nM_; nN = nN_; nZ = nZ_; G = G_; c = c_; }
    __device__ __forceinline__ bool next(int i, Unit& u) const {
        const int L = i * G + c; if (L >= nM * nN * nZ) return false;
        u.z = L / (nM * nN); const int r = L % (nM * nN); u.pm = r / nN; u.pn = r % nN; u.aux = 0; return true;
    }
    __device__ __forceinline__ const char* a_base(const Unit& u) const { return (const char*)(A + (size_t)u.z * sA) + (size_t)u.pm * BM * lda * 2; }
    __device__ __forceinline__ unsigned a_row(const Unit&, int r) const { return (unsigned)r * (unsigned)lda * 2u; }
    __device__ __forceinline__ const char* b_base(const Unit& u) const { return (const char*)(Bt + (size_t)u.z * sB) + (size_t)u.pn * BM * ldb * 2; }
};
template <bool GATHER_> struct MoeSched {
    static constexpr bool GATHER = GATHER_;
    const bf16_t* A; const bf16_t* Bt; size_t sB; int K, lda, ldb, nN, G, c;
    const LAS int* tp; const LAS int* cnt; const int* list;
    __device__ __forceinline__ bool next(int i, Unit& u) const {
        const int L = i * G + c; const int ntile = tp[NEXP]; if (L >= ntile * nN) return false;
        const int T = L / nN; u.pn = L % nN; int e = 0;
#pragma unroll 1
        for (int s = 16; s > 0; s >>= 1) if (tp[e + s] <= T) e += s;
        u.z = e; u.pm = T; u.aux = T - tp[e]; return true;
    }
    __device__ __forceinline__ const char* a_base(const Unit& u) const { return GATHER ? (const char*)A : (const char*)A + (size_t)u.pm * BM * lda * 2; }
    __device__ __forceinline__ unsigned a_row(const Unit& u, int r) const {
        if (GATHER) { const int idx = u.aux * BM + r; const int tok = list[u.z * NTOK + (idx < cnt[u.z] ? idx : 0)]; return (unsigned)tok * (unsigned)lda * 2u; }
        return (unsigned)r * (unsigned)lda * 2u;
    }
    __device__ __forceinline__ const char* b_base(const Unit& u) const { return (const char*)(Bt + (size_t)u.z * sB) + (size_t)u.pn * BM * ldb * 2; }
};

#define EPI_ROW(u, ai, m) ((u).pm * BM + (ai) * HALF + wr * 64 + (m) * 16 + fr)
#define EPI_COL8(u, bj) ((u).pn * BM + (bj) * HALF + wc * 32 + 8 * fq)
#define EPI_FOR_AM _Pragma("unroll") for (int ai = 0; ai < 2; ++ai) _Pragma("unroll") for (int m = 0; m < 4; ++m)
__device__ __forceinline__ u32x4 pack8(f32x4 v0, f32x4 v1) { u32x4 w; w.x = cvt_pk_bf16(v0[0], v0[1]); w.y = cvt_pk_bf16(v0[2], v0[3]); w.z = cvt_pk_bf16(v1[0], v1[1]); w.w = cvt_pk_bf16(v1[2], v1[3]); return w; }

struct EpiZ {
    static constexpr bool PERM = true;
    bf16_t* UP; bf16_t* ZF;
    __device__ __forceinline__ void operator()(const f32x4 (&acc)[2][2][4][2], const Unit& u, int wr, int wc, int fr, int fq) const {
        EPI_FOR_AM { const int row = EPI_ROW(u, ai, m);
#pragma unroll
            for (int bj = 0; bj < 2; ++bj) { const int col = EPI_COL8(u, bj); const u32x4 w = pack8(acc[ai][bj][m][0], acc[ai][bj][m][1]);
                if (u.pn < 2) { const int g = col >> 4, c0 = col & 15, j = row >> 5, i = row & 31; *(u32x4*)(UP + ((size_t)g * NCHP + j) * UPW + i * 16 + c0) = w; }
                else *(u32x4*)(ZF + (size_t)row * 512 + (col - 512)) = w; } }
    }
};
struct EpiG1 {
    static constexpr bool PERM = true;
    float* SLOC;
    __device__ __forceinline__ void operator()(const f32x4 (&acc)[2][2][4][2], const Unit& u, int wr, int wc, int fr, int fq) const {
        EPI_FOR_AM { const int row = EPI_ROW(u, ai, m); if (row < NCH) {
#pragma unroll
            for (int bj = 0; bj < 2; ++bj) { const int col = EPI_COL8(u, bj); float* p = SLOC + ((size_t)u.z * NCH + row) * 256 + col;
                *(f32x4*)p = acc[ai][bj][m][0]; *(f32x4*)(p + 4) = acc[ai][bj][m][1]; } } }
    }
};
__device__ __forceinline__ float gelu_tanh(float x) { const float t = 1.5957691216057308f * (x + 0.044715f * x * x * x); return x * fast_sigmoid(t); }
struct EpiG2 {
    static constexpr bool PERM = true;
    bf16_t* YG;
    __device__ __forceinline__ void operator()(const f32x4 (&acc)[2][2][4][2], const Unit& u, int wr, int wc, int fr, int fq) const {
        EPI_FOR_AM { const int row = EPI_ROW(u, ai, m); if (row < NCH) {
#pragma unroll
            for (int bj = 0; bj < 2; ++bj) { const int col = EPI_COL8(u, bj); const int i = col >> 4, c0 = col & 15; f32x4 v0 = acc[ai][bj][m][0], v1 = acc[ai][bj][m][1];
#pragma unroll
                for (int e = 0; e < 4; ++e) { v0[e] = gelu_tanh(v0[e]); v1[e] = gelu_tanh(v1[e]); }
                *(u32x4*)(YG + (size_t)(row * CHT + i) * 512 + u.z * 16 + c0) = pack8(v0, v1); } } }
    }
};
struct EpiBias16 {
    static constexpr bool PERM = true;
    bf16_t* O; int ldo, coff; const float* bias; int bstride;
    __device__ __forceinline__ void operator()(const f32x4 (&acc)[2][2][4][2], const Unit& u, int wr, int wc, int fr, int fq) const {
        const float* bp = bias + (size_t)u.z * bstride;
        f32x4 bv[2][2];
#pragma unroll
        for (int bj = 0; bj < 2; ++bj) { const int col = EPI_COL8(u, bj); bv[bj][0] = *(const f32x4*)(bp + col); bv[bj][1] = *(const f32x4*)(bp + col + 4); }
        EPI_FOR_AM { const int row = EPI_ROW(u, ai, m);
#pragma unroll
            for (int bj = 0; bj < 2; ++bj) { const int col = EPI_COL8(u, bj);
                *(u32x4*)(O + (size_t)row * ldo + coff + col) = pack8(acc[ai][bj][m][0] + bv[bj][0], acc[ai][bj][m][1] + bv[bj][1]); } }
    }
};
struct EpiGLU {
    static constexpr bool PERM = true;
    const bf16_t* YG; bf16_t* CAT; const float* bias;
    __device__ __forceinline__ void operator()(const f32x4 (&acc)[2][2][4][2], const Unit& u, int wr, int wc, int fr, int fq) const {
        f32x4 bv[2][2];
#pragma unroll
        for (int bj = 0; bj < 2; ++bj) { const int col = EPI_COL8(u, bj); bv[bj][0] = *(const f32x4*)(bias + col); bv[bj][1] = *(const f32x4*)(bias + col + 4); }
        EPI_FOR_AM { const int row = EPI_ROW(u, ai, m);
#pragma unroll
            for (int bj = 0; bj < 2; ++bj) { const int col = EPI_COL8(u, bj); const u32x4 yw = *(const u32x4*)(YG + (size_t)row * 512 + col);
                f32x4 v0 = acc[ai][bj][m][0] + bv[bj][0], v1 = acc[ai][bj][m][1] + bv[bj][1];
                v0[0] = bflo(yw.x) * fast_sigmoid(v0[0]); v0[1] = bfhi(yw.x) * fast_sigmoid(v0[1]); v0[2] = bflo(yw.y) * fast_sigmoid(v0[2]); v0[3] = bfhi(yw.y) * fast_sigmoid(v0[3]);
                v1[0] = bflo(yw.z) * fast_sigmoid(v1[0]); v1[1] = bfhi(yw.z) * fast_sigmoid(v1[1]); v1[2] = bflo(yw.w) * fast_sigmoid(v1[2]); v1[3] = bfhi(yw.w) * fast_sigmoid(v1[3]);
                *(u32x4*)(CAT + (size_t)row * 1024 + col) = pack8(v0, v1); } }
    }
};
struct EpiRes {
    static constexpr bool PERM = true;
    float* X; const float* gate_lat; const float* gate_ctx;
    __device__ __forceinline__ void operator()(const f32x4 (&acc)[2][2][4][2], const Unit& u, int wr, int wc, int fr, int fq) const {
        const float* gp = (u.pm == 0) ? gate_ctx : gate_lat;
        f32x4 gv[2][2];
#pragma unroll
        for (int bj = 0; bj < 2; ++bj) { const int col = EPI_COL8(u, bj); gv[bj][0] = *(const f32x4*)(gp + col); gv[bj][1] = *(const f32x4*)(gp + col + 4); }
        EPI_FOR_AM { const int row = EPI_ROW(u, ai, m);
#pragma unroll
            for (int bj = 0; bj < 2; ++bj) { const int col = EPI_COL8(u, bj); float* p = X + (size_t)row * DM + col;
                const f32x4 x0 = *(const f32x4*)p, x1 = *(const f32x4*)(p + 4);
                *(f32x4*)p = x0 * DN_ALPHA + gv[bj][0] * acc[ai][bj][m][0]; *(f32x4*)(p + 4) = x1 * DN_ALPHA + gv[bj][1] * acc[ai][bj][m][1]; } }
    }
};
struct EpiQKV {
    static constexpr bool PERM = false;
    bf16_t* QKV; const float* rope;
    __device__ __forceinline__ void operator()(const f32x4 (&acc)[2][2][4][2], const Unit& u, int wr, int wc, int fr, int fq) const {
        const bool do_rope = (u.pn < 8) && (u.pm > 0);
        EPI_FOR_AM { const int row = EPI_ROW(u, ai, m);
            f32x4 cs = {1.f, 1.f, 1.f, 1.f}, sn = {0.f, 0.f, 0.f, 0.f};
            if (do_rope) { const int t = row - CTX; const int pos = (wc & 1) ? (t & 63) : (t >> 6); const float* rp = rope + (size_t)pos * 32 + 8 * fq;
                const f32x4 a = *(const f32x4*)rp, b = *(const f32x4*)(rp + 4); cs = (f32x4){a[0], a[2], b[0], b[2]}; sn = (f32x4){a[1], a[3], b[1], b[3]}; }
#pragma unroll
            for (int bj = 0; bj < 2; ++bj) { const f32x4 x0 = acc[ai][bj][m][0], x1 = acc[ai][bj][m][1];
                const f32x4 o0 = x0 * cs - x1 * sn, o1 = x1 * cs + x0 * sn;
                const int col = u.pn * BM + bj * HALF + wc * 32 + 4 * fq; bf16_t* p = QKV + (size_t)row * 3072 + col;
                u32x2 w0, w1; w0.x = cvt_pk_bf16(o0[0], o0[1]); w0.y = cvt_pk_bf16(o0[2], o0[3]); w1.x = cvt_pk_bf16(o1[0], o1[1]); w1.y = cvt_pk_bf16(o1[2], o1[3]);
                *(u32x2*)p = w0; *(u32x2*)(p + 16) = w1; } }
    }
};
struct EpiSwiGLU {
    static constexpr bool PERM = true;
    bf16_t* ACT; const float* bg; const float* bu;
    __device__ __forceinline__ void operator()(const f32x4 (&acc)[2][2][4][2], const Unit& u, int wr, int wc, int fr, int fq) const {
        const int oc = u.pn * HALF + wc * 32 + 8 * fq;
        const float* pg = bg + (size_t)u.z * 1024 + oc; const float* pu = bu + (size_t)u.z * 1024 + oc;
        const f32x4 g0 = *(const f32x4*)pg, g1 = *(const f32x4*)(pg + 4), u0 = *(const f32x4*)pu, u1 = *(const f32x4*)(pu + 4);
        EPI_FOR_AM { const int row = EPI_ROW(u, ai, m);
            f32x4 a0 = acc[ai][0][m][0] + g0, a1 = acc[ai][0][m][1] + g1, b0 = acc[ai][1][m][0] + u0, b1 = acc[ai][1][m][1] + u1;
#pragma unroll
            for (int e = 0; e < 4; ++e) { float g = fminf(a0[e], 7.f), uu = fminf(fmaxf(b0[e], -7.f), 7.f); a0[e] = g * fast_sigmoid(1.702f * g) * (uu + 1.f);
                g = fminf(a1[e], 7.f); uu = fminf(fmaxf(b1[e], -7.f), 7.f); a1[e] = g * fast_sigmoid(1.702f * g) * (uu + 1.f); }
            *(u32x4*)(ACT + (size_t)row * 1024 + oc) = pack8(a0, a1); }
    }
};
}
__device__ __forceinline__ float wave_sum(float v) {
#pragma unroll
    for (int o = 1; o < 64; o <<= 1) v += __shfl_xor(v, o);
    return v;
}
__device__ __forceinline__ int brev7(int x) { return (int)(__brev((unsigned)x) >> 25); }

constexpr int FT_LD = 129;
template <bool DIM0> __device__ __forceinline__ void fft128(f32x2* T, const f32x2* tw, const int tid) {
    const int line = tid & 127, part = tid >> 7;
    const int sF = DIM0 ? FT_LD : 1, sL = DIM0 ? 1 : FT_LD;
    f32x2* base = T + line * sL;
#pragma unroll 1
    for (int half = 64; half >= 1; half >>= 1) {
        const int tstep = 64 / half;
#pragma unroll 4
        for (int q = 0; q < 16; ++q) {
            const int bf = part * 16 + q, k = bf & (half - 1), blk = bf / half, r0 = blk * 2 * half + k;
            const f32x2 a = base[r0 * sF], b = base[(r0 + half) * sF], w = tw[k * tstep];
            const f32x2 s = a + b, d = a - b;
            base[r0 * sF] = s;
            base[(r0 + half) * sF] = (f32x2){d.x * w.x - d.y * w.y, d.x * w.y + d.y * w.x};
        }
        __syncthreads();
    }
}
__device__ __forceinline__ void fft_a_unit(const bf16_t* ZF, f32x2* TT, int row0, int rstride, int g, float tw_turns  , float scale, f32x2* T, const f32x2* tw, const int tid) {
#pragma unroll
    for (int it = 0; it < 4; ++it) {
        const int p = tid + 512 * it, l1 = p >> 4, ch = (p & 15) * 8;
        const u32x4 w = *(const u32x4*)(ZF + (size_t)(row0 + rstride * l1) * 512 + g * 128 + ch);
        float v[8] = {bflo(w.x), bfhi(w.x), bflo(w.y), bfhi(w.y), bflo(w.z), bfhi(w.z), bflo(w.w), bfhi(w.w)};
        float s = 0.f;
#pragma unroll
        for (int e = 0; e < 8; ++e) s += v[e];
#pragma unroll
        for (int o = 1; o < 16; o <<= 1) s += __shfl_xor(s, o);
        const float mean = s * (1.f / 128.f); float q = 0.f;
#pragma unroll
        for (int e = 0; e < 8; ++e) { v[e] -= mean; q += v[e] * v[e]; }
#pragma unroll
        for (int o = 1; o < 16; o <<= 1) q += __shfl_xor(q, o);
        const float rstd = 1.0f / sqrtf(q * (1.f / 128.f) + LN_EPS);
#pragma unroll
        for (int e = 0; e < 8; ++e) T[l1 * FT_LD + ch + e] = (f32x2){v[e] * rstd, 0.f};
    }
    __syncthreads();
    fft128<false>(T, tw, tid);
    fft128<true>(T, tw, tid);
#pragma unroll 4
    for (int it = 0; it < 32; ++it) {
        const int p = tid + 512 * it, k1 = p >> 7, kc = p & 127;
        const f32x2 v = T[brev7(k1) * FT_LD + brev7(kc)];
        float sn, cs; sincospif(-2.0f * tw_turns * (float)k1, &sn, &cs);
        cs *= scale; sn *= scale;
        TT[(size_t)(row0 + rstride * k1) * 512 + g * 128 + kc] = (f32x2){v.x * cs - v.y * sn, v.x * sn + v.y * cs};
    }
    __syncthreads();
}
__device__ __forceinline__ void fft_b_unit(const f32x2* TT, bf16_t* SPEC, int in_row0, int out_row0, int g, f32x2* T, const f32x2* tw, const int tid) {
#pragma unroll 4
    for (int it = 0; it < 32; ++it) { const int p = tid + 512 * it, l2 = p >> 7, kc = p & 127; T[l2 * FT_LD + kc] = TT[(size_t)(in_row0 + l2) * 512 + g * 128 + kc]; }
    __syncthreads();
    fft128<true>(T, tw, tid);
#pragma unroll
    for (int it = 0; it < 4; ++it) {
        const int p = tid + 512 * it, k2 = p >> 4, kc = (p & 15) * 8; const f32x2* s = T + brev7(k2) * FT_LD + kc;
        u32x4 w; w.x = cvt_pk_bf16(s[0].x, s[1].x); w.y = cvt_pk_bf16(s[2].x, s[3].x); w.z = cvt_pk_bf16(s[4].x, s[5].x); w.w = cvt_pk_bf16(s[6].x, s[7].x);
        *(u32x4*)(SPEC + (size_t)(out_row0 + 128 * k2) * 512 + g * 128 + kc) = w;
    }
    __syncthreads();
}
namespace attn {
constexpr int NW = 8, QBLK = 32, KVBLK = 64, LDQ = 3072;
constexpr float SCALE = 0.125f;
constexpr float THR = 8.f;
constexpr int SHM_V = KVBLK * 128 * 2, SHM_K = KVBLK * 64 * 2, SHM_ATTN = 2 * SHM_V + 2 * SHM_K + NW * 64 * 4;
#define ASBAR() __builtin_amdgcn_sched_barrier(0)
#define KSWZ64(row, colB) ((row) * 128 + ((colB) ^ ((((row) >> 1) & 7) << 4)))
__device__ __forceinline__ int crow(int r, int hi) { return (r & 3) + 8 * (r >> 2) + 4 * hi; }
__device__ __forceinline__ void partialSM(f32x16& p0, f32x16& p1, float& m_reg, float& mn, float& alpha) {
  constexpr float C = SCALE * 1.4426950408889634f;
  float pmax = p0[0];
#pragma unroll
  for (int r = 1; r < 16; ++r) pmax = fmaxf(pmax, p0[r]);
#pragma unroll
  for (int r = 0; r < 16; ++r) pmax = fmaxf(pmax, p1[r]);
  { auto rr = __builtin_amdgcn_permlane32_swap(__float_as_uint(pmax), __float_as_uint(pmax), false, false);
    pmax = fmaxf(__uint_as_float(rr[0]), __uint_as_float(rr[1])); }
  if (__builtin_expect(__all(pmax - m_reg <= THR / SCALE), 1)) { mn = m_reg; alpha = 1.f; }
  else { mn = fmaxf(m_reg, pmax); alpha = __builtin_amdgcn_exp2f((m_reg - mn) * C); m_reg = mn; }
  const float mnC = -mn * C;
#pragma unroll
  for (int r = 0; r < 16; ++r) p0[r] = fmaf(p0[r], C, mnC);
#pragma unroll
  for (int r = 0; r < 16; ++r) p1[r] = fmaf(p1[r], C, mnC);
#pragma unroll
  for (int r = 0; r < 16; ++r) p0[r] = __builtin_amdgcn_exp2f(p0[r]);
}
__device__ __forceinline__ void finishSM(f32x16& p0, f32x16& p1, float alpha, float& l_reg, bf16x8& pa0, bf16x8& pa1, bf16x8& pa2, bf16x8& pa3) {
#pragma unroll
  for (int r = 0; r < 16; ++r) p1[r] = __builtin_amdgcn_exp2f(p1[r]);
  float ps = 0;
#pragma unroll
  for (int r = 0; r < 16; ++r) ps += p0[r];
#pragma unroll
  for (int r = 0; r < 16; ++r) ps += p1[r];
  { auto rr = __builtin_amdgcn_permlane32_swap(__float_as_uint(ps), __float_as_uint(ps), false, false);
    ps = __uint_as_float(rr[0]) + __uint_as_float(rr[1]); }
  l_reg = l_reg * alpha + ps;
#define PK4(P, BASE, OUT) do { unsigned a0 = cvt_pk_bf16(P[BASE + 0], P[BASE + 1]), a1 = cvt_pk_bf16(P[BASE + 2], P[BASE + 3]);   \
    unsigned b0 = cvt_pk_bf16(P[BASE + 4], P[BASE + 5]), b1 = cvt_pk_bf16(P[BASE + 6], P[BASE + 7]);                              \
    auto r0 = __builtin_amdgcn_permlane32_swap(a0, b0, false, false); auto r1 = __builtin_amdgcn_permlane32_swap(a1, b1, false, false); \
    u32x4 w = {r0[0], r1[0], r0[1], r1[1]}; OUT = *reinterpret_cast<bf16x8*>(&w); } while (0)
  PK4(p0, 0, pa0); PK4(p0, 8, pa1); PK4(p1, 0, pa2); PK4(p1, 8, pa3);
#undef PK4
}
__device__ __forceinline__ void qkt(f32x16& p0, f32x16& p1, const char* Ks, const bf16x8* qr, int r32, int hi) {
  p0 = f32x16{}; p1 = f32x16{};
#pragma unroll
  for (int d0 = 0; d0 < 4; ++d0) { const int cb = (d0 * 16 + hi * 8) * 2;
    const bf16x8 b0 = *reinterpret_cast<const bf16x8*>(Ks + KSWZ64(r32, cb));
    const bf16x8 b1 = *reinterpret_cast<const bf16x8*>(Ks + KSWZ64(32 + r32, cb));
    p0 = __builtin_amdgcn_mfma_f32_32x32x16_bf16(b0, qr[d0], p0, 0, 0, 0);
    p1 = __builtin_amdgcn_mfma_f32_32x32x16_bf16(b1, qr[d0], p1, 0, 0, 0); }
}
__device__ __forceinline__ int v_st(int k, int c) { const int kk = (k & ~0xC) | ((k & 4) << 1) | ((k & 8) >> 1); return ((kk >> 3) * 4 + (c >> 5)) * 512 + ((kk & 7) * 32 + (c & 31)) * 2; }
__device__ __forceinline__ int v_rd_base(int lane) { return ((lane & 3) << 3) | (((lane >> 2) & 3) << 6) | (((lane >> 4) & 1) << 5) | (((lane >> 5) & 1) << 8); }
constexpr int v_rd_off(int d0, int ks, int half) { return d0 * 512 + ks * 4096 + half * 2048; }
template <int OFF> __device__ __forceinline__ s16x4 tr_read(int vb) {
  s16x4 r; asm volatile("ds_read_b64_tr_b16 %0, %1 offset:%2" : "=&v"(r) : "v"(vb), "i"(OFF) : "memory"); return r;
}
template <int D0> __device__ __forceinline__ void pv_one(f32x16& od, int vb, bf16x8 pa0, bf16x8 pa1, bf16x8 pa2, bf16x8 pa3) {
  const s16x4 l0 = tr_read<v_rd_off(D0, 0, 0)>(vb), h0 = tr_read<v_rd_off(D0, 0, 1)>(vb), l1 = tr_read<v_rd_off(D0, 1, 0)>(vb), h1 = tr_read<v_rd_off(D0, 1, 1)>(vb);
  const s16x4 l2 = tr_read<v_rd_off(D0, 2, 0)>(vb), h2 = tr_read<v_rd_off(D0, 2, 1)>(vb), l3 = tr_read<v_rd_off(D0, 3, 0)>(vb), h3 = tr_read<v_rd_off(D0, 3, 1)>(vb);
  asm volatile("s_waitcnt lgkmcnt(0)" ::: "memory"); ASBAR();
#define PK(L, H) (bf16x8){L[0], L[1], L[2], L[3], H[0], H[1], H[2], H[3]}
  od = __builtin_amdgcn_mfma_f32_32x32x16_bf16(pa0, PK(l0, h0), od, 0, 0, 0);
  od = __builtin_amdgcn_mfma_f32_32x32x16_bf16(pa1, PK(l1, h1), od, 0, 0, 0);
  od = __builtin_amdgcn_mfma_f32_32x32x16_bf16(pa2, PK(l2, h2), od, 0, 0, 0);
  od = __builtin_amdgcn_mfma_f32_32x32x16_bf16(pa3, PK(l3, h3), od, 0, 0, 0);
#undef PK
}
__device__ __forceinline__ void pv_d0(f32x16* o, int vb, bf16x8 pa0, bf16x8 pa1, bf16x8 pa2, bf16x8 pa3) {
  pv_one<0>(o[0], vb, pa0, pa1, pa2, pa3); pv_one<1>(o[1], vb, pa0, pa1, pa2, pa3); pv_one<2>(o[2], vb, pa0, pa1, pa2, pa3); pv_one<3>(o[3], vb, pa0, pa1, pa2, pa3);
}
__device__ __forceinline__ void attn_unit(const bf16_t* __restrict__ Qb, const bf16_t* __restrict__ Kh, const bf16_t* __restrict__ Vh, float* __restrict__ Ob, int ldo, int seq, char* lds, const int tid) {
  const int wid = tid >> 6, lane = tid & 63, r32 = lane & 31, hi = lane >> 5;
  char* V_lds = lds; char* K_lds = lds + 2 * SHM_V;
  float* ws = (float*)(lds + 2 * SHM_V + 2 * SHM_K) + wid * 64; float* li_l = ws; float* al_l = ws + 32;
  float m_reg = -1e30f, l_reg = 0; f32x16 o[4] = {}; bf16x8 qr[4];
  const bf16_t* Qw = Qb + (long)(wid * QBLK + r32) * LDQ + hi * 8;
#pragma unroll
  for (int d0 = 0; d0 < 4; ++d0) qr[d0] = *reinterpret_cast<const bf16x8*>(Qw + d0 * 16);
  const int sr = tid >> 4, sc = (tid & 15) * 8, vst0 = v_st(sr, sc), vst1 = v_st(32 + sr, sc);
  const int ksr = tid >> 3, ksc = (tid & 7) * 8, kst = KSWZ64(ksr, ksc * 2);
  const int vb0 = (int)(uintptr_t)V_lds + v_rd_base(lane);
  struct { bf16x8 vs0, vs1, ks0; } sr_[2];
#define SLOAD(i, k0) do { sr_[i].vs0 = *reinterpret_cast<const bf16x8*>(&Vh[(long)((k0) + sr) * LDQ + sc]); sr_[i].vs1 = *reinterpret_cast<const bf16x8*>(&Vh[(long)((k0) + 32 + sr) * LDQ + sc]); \
    sr_[i].ks0 = *reinterpret_cast<const bf16x8*>(&Kh[(long)((k0) + ksr) * LDQ + ksc]); } while (0)
#define SWRITE(b, i) do { *(bf16x8*)(V_lds + (b) * SHM_V + vst0) = sr_[i].vs0; *(bf16x8*)(V_lds + (b) * SHM_V + vst1) = sr_[i].vs1; \
    *(bf16x8*)(K_lds + (b) * SHM_K + kst) = sr_[i].ks0; } while (0)
#define SWAIT() asm volatile("s_waitcnt vmcnt(3)" ::: "memory")
#define RESC(a) do { if (__any((a) < 1.f)) { if (hi == 0) al_l[r32] = (a); asm volatile("s_waitcnt lgkmcnt(0)" ::: "memory"); \
    _Pragma("unroll") for (int d = 0; d < 4; ++d) _Pragma("unroll") for (int r = 0; r < 16; ++r) o[d][r] *= al_l[crow(r, hi)]; } } while (0)
  f32x16 pA0, pA1, pB0, pB1; float mnA, mnB, alA, alB; bf16x8 pa0, pa1, pa2, pa3; const int NT = seq / KVBLK;
  constexpr int SE = 0, SO = 1;
  SLOAD(SE, 0); asm volatile("s_waitcnt vmcnt(0)" ::: "memory"); SWRITE(0, SE); __syncthreads();
  qkt(pA0, pA1, K_lds, qr, r32, hi); partialSM(pA0, pA1, m_reg, mnA, alA);
  SLOAD(SO, KVBLK); if (2 < NT) SLOAD(SE, 2 * KVBLK);
  SWAIT(); SWRITE(1, SO); __syncthreads();
  for (int j = 1; j + 1 < NT; j += 2) {
    ASBAR(); qkt(pB0, pB1, K_lds + SHM_K, qr, r32, hi);
    finishSM(pA0, pA1, alA, l_reg, pa0, pa1, pa2, pa3); ASBAR();
    SLOAD(SO, (j + 2) * KVBLK); ASBAR();
    pv_d0(o, vb0, pa0, pa1, pa2, pa3); partialSM(pB0, pB1, m_reg, mnB, alB);
    __syncthreads(); SWAIT(); SWRITE(0, SE);
    RESC(alB); __syncthreads();
    ASBAR(); qkt(pA0, pA1, K_lds, qr, r32, hi);
    finishSM(pB0, pB1, alB, l_reg, pa0, pa1, pa2, pa3); ASBAR();
    if (j + 3 < NT) SLOAD(SE, (j + 3) * KVBLK); ASBAR();
    pv_d0(o, vb0 + SHM_V, pa0, pa1, pa2, pa3); partialSM(pA0, pA1, m_reg, mnA, alA);
    __syncthreads(); SWAIT(); SWRITE(1, SO);
    RESC(alA); __syncthreads();
  }
  ASBAR(); qkt(pB0, pB1, K_lds + SHM_K, qr, r32, hi);
  finishSM(pA0, pA1, alA, l_reg, pa0, pa1, pa2, pa3); ASBAR();
  pv_d0(o, vb0, pa0, pa1, pa2, pa3); partialSM(pB0, pB1, m_reg, mnB, alB);
  __syncthreads(); RESC(alB);
  finishSM(pB0, pB1, alB, l_reg, pa0, pa1, pa2, pa3); ASBAR();
  pv_d0(o, vb0 + SHM_V, pa0, pa1, pa2, pa3);
  if (hi == 0) li_l[r32] = l_reg; asm volatile("s_waitcnt lgkmcnt(0)" ::: "memory");
  float rli[16];
#pragma unroll
  for (int r = 0; r < 16; ++r) rli[r] = __builtin_amdgcn_rcpf(li_l[crow(r, hi)]);
  float* Ow = Ob + (long)(wid * QBLK) * ldo;
#pragma unroll
  for (int r = 0; r < 16; ++r) { const int orow = crow(r, hi);
#pragma unroll
    for (int d0 = 0; d0 < 4; ++d0) Ow[(long)orow * ldo + d0 * 32 + r32] = o[d0][r] * rli[r]; }
  __syncthreads();
#undef SLOAD
#undef SWRITE
#undef SWAIT
#undef RESC
}
}
__device__ __forceinline__ int scan_chunk(int dir, int s) { return dir == 0 ? s : (s < NCH_CTX ? NCH_CTX - 1 - s : NCH - 1 - (s - NCH_CTX)); }
__device__ __forceinline__ void s5_scan_thread(int gt  , const float* SLOC, const f32x2* APOW, bf16_t* UP) {
    const int n = gt & 63, g = (gt >> 6) & 31, dir = gt >> 11;
    const f32x2 A = APOW[gt];
    const float* sl = SLOC + (size_t)g * NCH * 256 + dir * 128 + n;
    bf16_t* up = UP + (size_t)g * NCHP * UPW + 512 + dir * 128 + n;
    float hr = 0.f, hi = 0.f;
    constexpr int BATCH = 26;
#pragma unroll 1
    for (int s0 = 0; s0 < NCH; s0 += BATCH) {
        float sr[BATCH], si[BATCH];
#pragma unroll
        for (int b = 0; b < BATCH; ++b) { const int ch = scan_chunk(dir, s0 + b); sr[b] = sl[(size_t)ch * 256]; si[b] = sl[(size_t)ch * 256 + 64]; }
#pragma unroll
        for (int b = 0; b < BATCH; ++b) { const int ch = scan_chunk(dir, s0 + b);
            up[(size_t)ch * UPW] = (bf16_t)(cvt_pk_bf16(hr, 0.f) & 0xffffu); up[(size_t)ch * UPW + 64] = (bf16_t)(cvt_pk_bf16(hi, 0.f) & 0xffffu);
            const float nr = A.x * hr - A.y * hi + sr[b], ni = A.x * hi + A.y * hr + si[b]; hr = nr; hi = ni; }
    }
}

__device__ __forceinline__ void ln_router_row(int row, float* X, bf16_t* H2, const float* lng, const float* lnb, const float* shift, const float* scale,
                                              const float* wr_lds, const float* br, int* TOPI, float* TOPW, int* TOPS, int* LIST, unsigned* cnt, int lane) {
    f32x4* xr = (f32x4*)(X + (size_t)row * DM) + lane;
    f32x4 v[4]; float s = 0.f;
#pragma unroll
    for (int j = 0; j < 4; ++j) { v[j] = xr[64 * j]; s += (v[j][0] + v[j][1]) + (v[j][2] + v[j][3]); }
    const float mean = wave_sum(s) * (1.f / DM); float s2 = 0.f;
#pragma unroll
    for (int j = 0; j < 4; ++j) { v[j] = v[j] - mean; s2 += (v[j][0] * v[j][0] + v[j][1] * v[j][1]) + (v[j][2] * v[j][2] + v[j][3] * v[j][3]); }
    const float rstd = 1.f / sqrtf(wave_sum(s2) * (1.f / DM) + LN_EPS);
    f32x4 h[4];
#pragma unroll
    for (int j = 0; j < 4; ++j) { const int c = 4 * lane + 256 * j;
        const f32x4 g = *(const f32x4*)(lng + c), b = *(const f32x4*)(lnb + c), sh = *(const f32x4*)(shift + c), sc = *(const f32x4*)(scale + c);
        v[j] = v[j] * rstd * g + b; xr[64 * j] = v[j];
        h[j] = v[j] * (sc + 1.0f) + sh;
        u32x2 w; w.x = cvt_pk_bf16(h[j][0], h[j][1]); w.y = cvt_pk_bf16(h[j][2], h[j][3]);
        *(u32x2*)(H2 + (size_t)row * DM + c) = w; }
    float lg[NEXP];
#pragma unroll
    for (int e = 0; e < NEXP; ++e) { float a = 0.f;
#pragma unroll
        for (int j = 0; j < 4; ++j) { const f32x4 w = *(const f32x4*)(wr_lds + e * DM + 4 * lane + 256 * j); a += (h[j][0] * w[0] + h[j][1] * w[1]) + (h[j][2] * w[2] + h[j][3] * w[3]); }
        lg[e] = a; }
#pragma unroll
    for (int e = 0; e < NEXP; ++e) lg[e] = wave_sum(lg[e]) + br[e];
    int ti[TOPK]; float tv[TOPK];
#pragma unroll
    for (int k = 0; k < TOPK; ++k) { float best = -3.0e38f; int bi = 0;
#pragma unroll
        for (int e = 0; e < NEXP; ++e) { const bool taken = (k > 0 && ti[0] == e) || (k > 1 && ti[1] == e) || (k > 2 && ti[2] == e); if (!taken && lg[e] > best) { best = lg[e]; bi = e; } }
        ti[k] = bi; tv[k] = best; }
    float ex[TOPK], es = 0.f;
#pragma unroll
    for (int k = 0; k < TOPK; ++k) { ex[k] = __expf(tv[k] - tv[0]); es += ex[k]; }
    if (lane < TOPK) {
        const int e = lane == 0 ? ti[0] : lane == 1 ? ti[1] : lane == 2 ? ti[2] : ti[3];
        const float w = (lane == 0 ? ex[0] : lane == 1 ? ex[1] : lane == 2 ? ex[2] : ex[3]) / es;
        const unsigned slot = atomicAdd(cnt + e, 1u);
        TOPI[row * TOPK + lane] = e; TOPW[row * TOPK + lane] = w; TOPS[row * TOPK + lane] = (int)slot;
        LIST[(size_t)e * NTOK + slot] = row;
    }
}
__device__ __forceinline__ void moe_combine_row(int row, float* X, const bf16_t* YD, const int* TOPI, const float* TOPW, const int* TOPS, const LAS int* tp, const float* gate,
                                                const float* lng, const float* lnb, const float* nshift, const float* nscale, bf16_t* Hn, float* out, int lane) {
    f32x4* xr = (f32x4*)(X + (size_t)row * DM) + lane;
    f32x4 y[4] = {};
#pragma unroll
    for (int k = 0; k < TOPK; ++k) { const int e = TOPI[row * TOPK + k]; const float w = TOPW[row * TOPK + k]; const size_t dr = (size_t)tp[e] * 256 + TOPS[row * TOPK + k];
        const u32x2* yp = (const u32x2*)(YD + dr * DM) + lane;
#pragma unroll
        for (int j = 0; j < 4; ++j) { const u32x2 q = yp[64 * j]; y[j][0] += w * bflo(q.x); y[j][1] += w * bfhi(q.x); y[j][2] += w * bflo(q.y); y[j][3] += w * bfhi(q.y); } }
    f32x4 v[4]; float s = 0.f;
#pragma unroll
    for (int j = 0; j < 4; ++j) { const f32x4 g = *(const f32x4*)(gate + 4 * lane + 256 * j); v[j] = xr[64 * j] * DN_ALPHA + g * y[j]; s += (v[j][0] + v[j][1]) + (v[j][2] + v[j][3]); }
    const float mean = wave_sum(s) * (1.f / DM); float s2 = 0.f;
#pragma unroll
    for (int j = 0; j < 4; ++j) { v[j] = v[j] - mean; s2 += (v[j][0] * v[j][0] + v[j][1] * v[j][1]) + (v[j][2] * v[j][2] + v[j][3] * v[j][3]); }
    const float rstd = 1.f / sqrtf(wave_sum(s2) * (1.f / DM) + LN_EPS);
#pragma unroll
    for (int j = 0; j < 4; ++j) { const int c = 4 * lane + 256 * j;
        const f32x4 g = *(const f32x4*)(lng + c), b = *(const f32x4*)(lnb + c);
        v[j] = v[j] * rstd * g + b; xr[64 * j] = v[j];
        if (Hn) { const f32x4 sh = *(const f32x4*)(nshift + c), sc = *(const f32x4*)(nscale + c); const f32x4 hh = v[j] * (sc + 1.0f) + sh;
            u32x2 w; w.x = cvt_pk_bf16(hh[0], hh[1]); w.y = cvt_pk_bf16(hh[2], hh[3]); *(u32x2*)(Hn + (size_t)row * DM + c) = w; }
        if (out && row >= CTX) *(f32x4*)(out + (size_t)(row - CTX) * DM + c) = v[j]; }
}
__device__ __forceinline__ void diff_combine_row(int row, const float* OA, bf16_t* OB, float lam, const float* subg, float post, int lane) {
    const int head = lane >> 3, d0 = (lane & 7) * 16;
    const float* p1 = OA + (size_t)row * 2048 + (2 * head) * 128 + d0; const float* p2 = p1 + 128;
    float o[16]; float q = 0.f;
#pragma unroll
    for (int j = 0; j < 4; ++j) { const f32x4 a = *(const f32x4*)(p1 + 4 * j), b = *(const f32x4*)(p2 + 4 * j);
#pragma unroll
        for (int e = 0; e < 4; ++e) { o[4 * j + e] = a[e] - lam * b[e]; q += o[4 * j + e] * o[4 * j + e]; } }
    q += __shfl_xor(q, 1); q += __shfl_xor(q, 2); q += __shfl_xor(q, 4);
    const float r = post / sqrtf(q * (1.f / 128.f) + LN_EPS);
    u32x4 w0, w1;
    const f32x4 g0 = *(const f32x4*)(subg + d0), g1 = *(const f32x4*)(subg + d0 + 4), g2 = *(const f32x4*)(subg + d0 + 8), g3 = *(const f32x4*)(subg + d0 + 12);
    w0.x = cvt_pk_bf16(o[0] * r * g0[0], o[1] * r * g0[1]); w0.y = cvt_pk_bf16(o[2] * r * g0[2], o[3] * r * g0[3]); w0.z = cvt_pk_bf16(o[4] * r * g1[0], o[5] * r * g1[1]); w0.w = cvt_pk_bf16(o[6] * r * g1[2], o[7] * r * g1[3]);
    w1.x = cvt_pk_bf16(o[8] * r * g2[0], o[9] * r * g2[1]); w1.y = cvt_pk_bf16(o[10] * r * g2[2], o[11] * r * g2[3]); w1.z = cvt_pk_bf16(o[12] * r * g3[0], o[13] * r * g3[1]); w1.w = cvt_pk_bf16(o[14] * r * g3[2], o[15] * r * g3[3]);
    bf16_t* op = OB + (size_t)row * DM + head * 128 + d0; *(u32x4*)op = w0; *(u32x4*)(op + 8) = w1;
}
__device__ __forceinline__ void transpose_item(const float* W, int K, int N, bf16_t* WT, int ldk, int mode, int roff, int koff, LAS float* scr, int item, int lane) {
    const int nblk = N / 32, kb = item / nblk, nb = item % nblk, k0 = 64 * kb, n0 = 32 * nb;
#pragma unroll 8
    for (int i = 0; i < 32; ++i) { const int kk = 2 * i + (lane >> 5); scr[kk * 33 + (lane & 31)] = W[(size_t)(k0 + kk) * N + n0 + (lane & 31)]; }
    asm volatile("s_waitcnt lgkmcnt(0)" ::: "memory");
    const int c = lane & 7;
    const int d0 = (mode == 1 || mode == 2) ? ((n0 >> 7) * 256 + (n0 & 127) + (mode == 2 ? 128 : 0)) : (roff + n0);
#pragma unroll
    for (int j = 0; j < 4; ++j) { const int n = (lane >> 3) + 8 * j; const LAS float* s = scr + (8 * c) * 33 + n;
        u32x4 o; o.x = cvt_pk_bf16(s[0 * 33], s[1 * 33]); o.y = cvt_pk_bf16(s[2 * 33], s[3 * 33]); o.z = cvt_pk_bf16(s[4 * 33], s[5 * 33]); o.w = cvt_pk_bf16(s[6 * 33], s[7 * 33]);
        *(u32x4*)(WT + (size_t)(d0 + n) * ldk + koff + k0 + 8 * c) = o; }
    asm volatile("s_waitcnt lgkmcnt(0)" ::: "memory");
}
__device__ __forceinline__ float silu_f(float v) { return v / (1.0f + __expf(-v)); }
__device__ __forceinline__ f32x2 cmul(f32x2 a, f32x2 b) { return (f32x2){a.x * b.x - a.y * b.y, a.x * b.y + a.y * b.x}; }
constexpr size_t MiB = 1u << 20;
constexpr size_t al1m(size_t x) { return (x + MiB - 1) / MiB * MiB; }
constexpr size_t WS_CTL = 0, CTL_ZERO_BYTES = 1 * MiB;
constexpr size_t WS_WFN = 1 * MiB;
constexpr size_t WS_WGU = 2 * MiB;
constexpr size_t WS_WD = WS_WGU + (size_t)4 * 32 * 2048 * 1024 * 2;
constexpr size_t WS_WIN = WS_WD + (size_t)4 * 32 * 1024 * 1024 * 2;
constexpr size_t WS_WGLU = WS_WIN + 4 * MiB;
constexpr size_t WS_WOUT = WS_WGLU + 1 * MiB;
constexpr size_t WS_WQKV = WS_WOUT + 4 * MiB;
constexpr size_t WS_WO = WS_WQKV + 12 * MiB;
constexpr size_t WS_MS = WS_WO + 4 * MiB;
constexpr size_t WS_KM = WS_MS + 16 * MiB;
constexpr size_t WS_POW = WS_KM + 48 * MiB;
constexpr size_t WS_BBAR = WS_POW + 3 * MiB;
constexpr size_t WS_APOW = WS_BBAR + 1 * MiB;
constexpr size_t WS_MOD = WS_APOW + 1 * MiB;
constexpr size_t WS_PART = WS_MOD + 1 * MiB;
constexpr size_t WS_ROPE = WS_PART + 3 * MiB;
constexpr size_t WS_RWT = WS_ROPE + 1 * MiB;
constexpr size_t WS_X = WS_RWT + 1 * MiB;
constexpr size_t WS_H = WS_X + al1m((size_t)NTOK * DM * 4);
constexpr size_t WS_H2 = WS_H + al1m((size_t)NTOK * DM * 2);
constexpr size_t WS_UP = WS_H2 + al1m((size_t)NTOK * DM * 2);
constexpr size_t WS_SLOC = WS_UP + al1m((size_t)S5G * NCHP * UPW * 2);
constexpr size_t WS_ZF = WS_SLOC + al1m((size_t)S5G * NCH * 256 * 4);
constexpr size_t WS_TT = WS_ZF + al1m((size_t)NTOK * 512 * 2);
constexpr size_t WS_SPEC = WS_TT + al1m((size_t)NTOK * 512 * 8);
constexpr size_t WS_YG = WS_SPEC + al1m((size_t)NTOK * 512 * 2);
constexpr size_t WS_CAT = WS_YG + al1m((size_t)NTOK * 512 * 2);
constexpr size_t WS_QKV = WS_CAT + al1m((size_t)NTOK * DM * 2);
constexpr size_t WS_OA = WS_QKV + al1m((size_t)NTOK * 3072 * 2);
constexpr size_t WS_OB = WS_OA + al1m((size_t)NTOK * 2048 * 4);
constexpr size_t WS_TOPI = WS_OB + al1m((size_t)NTOK * DM * 2);
constexpr size_t WS_TOPW = WS_TOPI + 1 * MiB;
constexpr size_t WS_TOPS = WS_TOPW + 1 * MiB;
constexpr size_t WS_LIST = WS_TOPS + 1 * MiB;
constexpr int MAXROWS = (NTOK * TOPK / 256 + NEXP) * 256;
constexpr size_t WS_ACT = WS_LIST + 3 * MiB;
constexpr size_t WS_YD = WS_ACT + al1m((size_t)MAXROWS * DM * 2);
constexpr size_t WS_END = WS_YD + al1m((size_t)MAXROWS * DM * 2);
static_assert(WS_END <= (size_t)2048 * MiB, "workspace map exceeds 2 GiB");
constexpr int CW_BAR = 4096;
constexpr int CW_CNT = 240000;
constexpr int NPHASE = 43;

constexpr int SCR_BYTES = 135168;
constexpr int LDS_TP = SCR_BYTES;
constexpr int LDS_CNT = SCR_BYTES + 160;
constexpr int LDS_MISC = SCR_BYTES + 320;
constexpr int LDS_BYTES = 147456;

#define XB_TMO      128
#define XB_XCNT(j)  (256  + 64 * (j))
#define XB_XSUB(j)  (1280 + 64 * (j))
#define XB_XGEN(j)  (2304 + 64 * (j))
#define XB_TOP      3328
#define XB_TOPGEN   3392
#define XCD_BAR_WORDS 3456
#define XB_SPIN_CAP (1u << 18)
__device__ __forceinline__ unsigned xb_ld(unsigned* p)              { return __hip_atomic_load(p, __ATOMIC_RELAXED, __HIP_MEMORY_SCOPE_AGENT); }
__device__ __forceinline__ unsigned xb_add(unsigned* p, unsigned v) { return __hip_atomic_fetch_add(p, v, __ATOMIC_RELAXED, __HIP_MEMORY_SCOPE_AGENT); }
__device__ __forceinline__ unsigned xb_xcc_id() { return (unsigned)__builtin_amdgcn_s_getreg((3 << 11) | 20) & 0xFu; }
#define XB_SPIN(cond, bar) do { unsigned _sp = 0; while (cond) { __builtin_amdgcn_s_sleep(1); \
    if ((++_sp & 255u) == 0u) { if (xb_ld(&(bar)[XB_TMO])) break; if (_sp > XB_SPIN_CAP) { atomicAdd(&(bar)[XB_TMO], 1u); break; } } } } while (0)
struct XcdBarrier { unsigned* bar; unsigned x; volatile LAS unsigned* st; };
__device__ __forceinline__ XcdBarrier xcd_barrier_post(unsigned* bar, volatile LAS unsigned* st) {
    XcdBarrier b; b.bar = bar; b.x = xb_xcc_id(); b.st = st;
    if (threadIdx.x == 0) (void)xb_add(&bar[XB_XCNT(b.x)], 1u);
    return b;
}
__device__ __forceinline__ void xcd_barrier_complete(unsigned* bar, unsigned x, unsigned& nloc, unsigned& nx) {
    const unsigned G = gridDim.x * gridDim.y * gridDim.z;
    unsigned sum, cnt, mine, sp = 0u;
    for (;;) {
        sum = 0u; cnt = 0u; mine = 0u;
#pragma unroll
        for (unsigned j = 0; j < 16; ++j) { const unsigned c = xb_ld(&bar[XB_XCNT(j)]); sum += c; cnt += (c > 0u) ? 1u : 0u; mine = (j == x) ? c : mine; }
        if (sum == G) break;
        __builtin_amdgcn_s_sleep(1);
        if ((++sp & 255u) == 0u) { if (xb_ld(&bar[XB_TMO])) break; if (sp > XB_SPIN_CAP) { atomicAdd(&bar[XB_TMO], 1u); break; } }
    }
    nloc = mine > 0u ? mine : 1u; nx = cnt > 0u ? cnt : 1u;
}
__device__ __forceinline__ void xcd_barrier(const XcdBarrier& b) {
    asm volatile("s_waitcnt vmcnt(0)" ::: "memory");
    __syncthreads();
    if (threadIdx.x == 0) {
        unsigned* bar = b.bar;
        __builtin_amdgcn_s_waitcnt(0);
        unsigned nloc = b.st[0], nx = b.st[1];
        if (nloc == 0u) { xcd_barrier_complete(bar, b.x, nloc, nx); b.st[0] = nloc; b.st[1] = nx; }
        const unsigned old = xb_add(&bar[XB_XSUB(b.x)], 1u);
        const unsigned gen = old / nloc;
        if (old + 1u == (gen + 1u) * nloc) {
            __builtin_amdgcn_fence(__ATOMIC_RELEASE, "agent");
            asm volatile("s_waitcnt vmcnt(0)" ::: "memory");
            const unsigned og = xb_add(&bar[XB_TOP], 1u);
            const unsigned tg = og / nx;
            if (og + 1u == (tg + 1u) * nx) xb_add(&bar[XB_TOPGEN], 1u);
            else XB_SPIN(xb_ld(&bar[XB_TOPGEN]) == tg, bar);
            __builtin_amdgcn_fence(__ATOMIC_ACQUIRE, "agent");
            xb_add(&bar[XB_XGEN(b.x)], 1u);
            asm volatile("s_waitcnt vmcnt(0)" ::: "memory");
        } else {
            XB_SPIN(xb_ld(&bar[XB_XGEN(b.x)]) == gen, bar);
            __builtin_amdgcn_fence(__ATOMIC_ACQUIRE, "agent");
            asm volatile("s_waitcnt vmcnt(0)" ::: "memory");
        }
    }
    __syncthreads();
}

#ifndef MK_SITES
#define MK_SITES 0xffffffffull
#endif
#define SITE(n) ((((unsigned long long)(MK_SITES)) >> (n)) & 1ull)
struct Args { const float* in[37]; float* out; unsigned char* ws; int ph_lo, ph_hi, li, pad; };
enum { I_X = 0, I_C, I_CTX, I_CCTX, I_ADAW, I_ADAB, I_LNG, I_LNB, I_WIN, I_LAMRE, I_LAMIM, I_LOGDT, I_BRE, I_BIM, I_CRE, I_CIM, I_S5D, I_WGLU, I_BGLU, I_FNW, I_FNB, I_WOUT,
       I_WQKV, I_WO, I_LQ1, I_LK1, I_LQ2, I_LK2, I_SUBG, I_RW, I_RB, I_WG, I_BG, I_WU, I_BU, I_WDN, I_BDN };

__device__ __forceinline__ void moe_tiles_to_lds(const unsigned* cntg, LAS int* tp, LAS int* cnt, int tid) {
    if (tid < 64) { int c = tid < NEXP ? (int)cntg[tid] : 0; if (tid < NEXP) cnt[tid] = c; int t = (c + 255) >> 8;
#pragma unroll
        for (int o = 1; o < 32; o <<= 1) { const int v = __shfl_up(t, o); if ((tid & 63) >= o) t += v; }
        if (tid < NEXP) tp[tid + 1] = t; if (tid == 0) tp[0] = 0; }
    __syncthreads();
}

#define WGU ((bf16_t*)(wsl + WS_WGU))
#define WD ((bf16_t*)(wsl + WS_WD))
#define WIN ((bf16_t*)(wsl + WS_WIN))
#define WGLU ((bf16_t*)(wsl + WS_WGLU))
#define WFN ((bf16_t*)(wsl + WS_WFN))
#define WOUT ((bf16_t*)(wsl + WS_WOUT))
#define WQKV ((bf16_t*)(wsl + WS_WQKV))
#define WO ((bf16_t*)(wsl + WS_WO))
#define MS ((bf16_t*)(wsl + WS_MS))
#define KM ((bf16_t*)(wsl + WS_KM))
#define POW ((f32x2*)(wsl + WS_POW))
#define BBAR ((f32x2*)(wsl + WS_BBAR))
#define APOW ((f32x2*)(wsl + WS_APOW))
#define MOD ((float*)(wsl + WS_MOD))
#define PART ((float*)(wsl + WS_PART))
#define ROPE ((float*)(wsl + WS_ROPE))
#define RWT ((float*)(wsl + WS_RWT))
#define X ((float*)(wsl + WS_X))
#define H ((bf16_t*)(wsl + WS_H))
#define H2 ((bf16_t*)(wsl + WS_H2))
#define UP ((bf16_t*)(wsl + WS_UP))
#define SLOC ((float*)(wsl + WS_SLOC))
#define ZF ((bf16_t*)(wsl + WS_ZF))
#define TT ((f32x2*)(wsl + WS_TT))
#define SPEC ((bf16_t*)(wsl + WS_SPEC))
#define YG ((bf16_t*)(wsl + WS_YG))
#define CAT ((bf16_t*)(wsl + WS_CAT))
#define QKV ((bf16_t*)(wsl + WS_QKV))
#define OA ((float*)(wsl + WS_OA))
#define OB ((bf16_t*)(wsl + WS_OB))
#define TOPI ((int*)(wsl + WS_TOPI))
#define TOPW ((float*)(wsl + WS_TOPW))
#define TOPS ((int*)(wsl + WS_TOPS))
#define LIST ((int*)(wsl + WS_LIST))
#define ACT ((bf16_t*)(wsl + WS_ACT))
#define YD ((bf16_t*)(wsl + WS_YD))
#define CTLW ((unsigned*)(wsl + WS_CTL))
#define PHASE_BEGIN unsigned char* wsl = args.ws; asm volatile("" : "+s"(wsl)); const float* const* in = args.in; \
    int tid = threadIdx.x; asm volatile("" : "+v"(tid)); const int lane = tid & 63, wave = __builtin_amdgcn_readfirstlane(tid >> 6), gw = bx * 8 + wave; (void)lane; (void)gw;
__global__ void __launch_bounds__(512, 2) mega(Args args) {
    extern __shared__ __attribute__((aligned(16))) unsigned char lds[];
    LAS unsigned char* ldsl = (LAS unsigned char*)lds;
    const int tid = threadIdx.x, lane = tid & 63, wave = __builtin_amdgcn_readfirstlane(tid >> 6);
    const int G = gridDim.x, bx = blockIdx.x;
    const int vcu = (G % 8 == 0) ? (bx % 8) * (G / 8) + bx / 8 : bx;
    const int gw = bx * 8 + wave, NGW = G * 8;
    unsigned char* ws = args.ws;
    unsigned* ctl = (unsigned*)(ws + WS_CTL);
    for (int u = tid; u < (LDS_BYTES - SCR_BYTES) / 4; u += 512) ((LAS unsigned*)(ldsl + SCR_BYTES))[u] = 0u;
    __syncthreads();
    volatile LAS unsigned* MISC = (volatile LAS unsigned*)(ldsl + LDS_MISC);
    LAS int* tp = (LAS int*)(ldsl + LDS_TP); LAS int* cntl = (LAS int*)(ldsl + LDS_CNT);
    XcdBarrier bar = xcd_barrier_post(ctl + CW_BAR + args.li * XCD_BAR_WORDS, MISC + 8);
    const int lo = args.ph_lo, hi = args.ph_hi;
#define IN(k) (lo <= (k) && (k) < hi)
#define SEAM(k) do { if (IN(k) && (k) + 1 < hi) xcd_barrier(bar); } while (0)


    if (SITE(0) && IN(0)) { PHASE_BEGIN
        LAS float* scr = (LAS float*)(ldsl + wave * 16384);
        constexpr int MOE_ITEMS = 384 * 512;
        constexpr int I_SM0 = MOE_ITEMS, I_SM1 = I_SM0 + 2 * 512  , I_SM2 = I_SM1 + 2 * 128  , I_SM3 = I_SM2 + 2 * 4 * 8  , I_SM4 = I_SM3 + 2 * 512  ,
                      I_SM5 = I_SM4 + 2 * 1536  , I_SM6 = I_SM5 + 2 * 512  ;
        for (int it = gw; it < I_SM6; it += NGW) {
            if (it < MOE_ITEMS) { const int m = it >> 9, r = it & 511;
                if (m < 128) transpose_item(in[I_WG] + (size_t)m * 1048576, 1024, 1024, WGU + (size_t)m * 2097152, 1024, 1, 0, 0, scr, r, lane);
                else if (m < 256) transpose_item(in[I_WU] + (size_t)(m - 128) * 1048576, 1024, 1024, WGU + (size_t)(m - 128) * 2097152, 1024, 2, 0, 0, scr, r, lane);
                else transpose_item(in[I_WDN] + (size_t)(m - 256) * 1048576, 1024, 1024, WD + (size_t)(m - 256) * 1048576, 1024, 0, 0, 0, scr, r, lane);
            } else if (it < I_SM1) { const int r = it - I_SM0, i = r >> 9; transpose_item(in[I_WIN] + (size_t)i * 1048576, 1024, 1024, WIN + (size_t)i * 1048576, 1024, 0, 0, 0, scr, r & 511, lane); }
            else if (it < I_SM2) { const int r = it - I_SM1, i = r >> 7; transpose_item(in[I_WGLU] + (size_t)i * 262144, 512, 512, WGLU + (size_t)i * 262144, 512, 0, 0, 0, scr, r & 127, lane); }
            else if (it < I_SM3) { const int r = it - I_SM2, ig = r >> 3, i = ig >> 2, g = ig & 3; transpose_item(in[I_FNW] + (size_t)ig * 16384, 128, 128, WFN + (size_t)i * 262144, 512, 3, g * 128, g * 128, scr, r & 7, lane); }
            else if (it < I_SM4) { const int r = it - I_SM3, i = r >> 9; transpose_item(in[I_WOUT] + (size_t)i * 1048576, 1024, 1024, WOUT + (size_t)i * 1048576, 1024, 0, 0, 0, scr, r & 511, lane); }
            else if (it < I_SM5) { const int r = it - I_SM4, i = r / 1536; transpose_item(in[I_WQKV] + (size_t)i * 3145728, 1024, 3072, WQKV + (size_t)i * 3145728, 1024, 0, 0, 0, scr, r % 1536, lane); }
            else { const int r = it - I_SM5, i = r >> 9; transpose_item(in[I_WO] + (size_t)i * 1048576, 1024, 1024, WO + (size_t)i * 1048576, 1024, 0, 0, 0, scr, r & 511, lane); }
        }
        for (int it = gw; it < 16 * 4 * 24; it += NGW) {
            const int nb = it % 24, l = (it / 24) & 3, kb = it / 96;
            const float al = silu_f(in[I_C][kb * 64 + lane]), ac = silu_f(in[I_CCTX][kb * 64 + lane]);
            const float* wp = in[I_ADAW] + ((size_t)l * 1024 + kb * 64) * 6144 + nb * 256 + 4 * lane;
            f32x4 sl = {0.f, 0.f, 0.f, 0.f}, sc = {0.f, 0.f, 0.f, 0.f};
#pragma unroll 8
            for (int kk = 0; kk < 64; ++kk) { const f32x4 w = *(const f32x4*)(wp + (size_t)kk * 6144); const float a = __shfl(al, kk), b = __shfl(ac, kk); sl += w * a; sc += w * b; }
            float* pp = PART + ((size_t)(kb * 4 + l) * 2) * 6144 + nb * 256 + 4 * lane;
            *(f32x4*)pp = sl; *(f32x4*)(pp + 6144) = sc;
        }
        for (int t = bx * 512 + tid; t < 8192; t += G * 512) {
            const int n = t & 63, g = (t >> 6) & 31, dir = (t >> 11) & 1, i = t >> 12;
            const int gi = (i * 2 + dir) * 32 + g;
            const double lre = (double)in[I_LAMRE][gi * 64 + n], lim = (double)in[I_LAMIM][gi * 64 + n], dt = exp((double)in[I_LOGDT][gi]);
            f32x2* pw = POW + (size_t)(gi * 64 + n) * 33;
            double br = 0, bi = 0;
            for (int k = 0; k <= 32; ++k) { const double mag = exp(k * dt * lre); double sn, cs; sincos(k * dt * lim, &sn, &cs); pw[k] = (f32x2){(float)(mag * cs), (float)(mag * sn)};
                if (k == 1) { br = mag * cs; bi = mag * sn; } if (k == 32) APOW[i * 4096 + (dir * 32 + g) * 64 + n] = (f32x2){(float)(mag * cs), (float)(mag * sn)}; }
            const double nr = br - 1.0, ni = bi, den = lre * lre + lim * lim; const double cr = (nr * lre + ni * lim) / den, ci = (ni * lre - nr * lim) / den;
            for (int c = 0; c < 16; ++c) { const double xr = (double)in[I_BRE][(size_t)(gi * 64 + n) * 16 + c], xi = (double)in[I_BIM][(size_t)(gi * 64 + n) * 16 + c];
                BBAR[(size_t)(gi * 64 + n) * 16 + c] = (f32x2){(float)(cr * xr - ci * xi), (float)(cr * xi + ci * xr)}; }
        }
        for (int t = bx * 512 + tid; t < 256 * 16; t += G * 512) { const int pos = t >> 4, f = t & 15; const double th = pow(10000.0, -(double)f / 16.0); double sn, cs; sincos((double)pos * th, &sn, &cs);
            ROPE[t * 2] = (float)cs; ROPE[t * 2 + 1] = (float)sn; }
        for (int t = bx * 512 + tid; t < 4 * 32768; t += G * 512) { const int l = t >> 15, r = t & 32767, c = r >> 5, e = r & 31; RWT[(size_t)l * 32768 + e * 1024 + c] = in[I_RW][t]; }
    }
    SEAM(0);
    if (SITE(1) && IN(1)) { PHASE_BEGIN
        for (int t = bx * 512 + tid; t < 4 * 2 * 6144; t += G * 512) { const int n = t % 6144, ls = t / 6144, l = ls >> 1; float s = in[I_ADAB][l * 6144 + n];
#pragma unroll
            for (int kb = 0; kb < 16; ++kb) s += PART[((size_t)kb * 8 + ls) * 6144 + n];
            MOD[t] = s; }
        float* KT = (float*)lds;
        for (int u = bx; u < 256; u += G) {
            const int q = u & 3, g = (u >> 2) & 31, i = u >> 7;
            for (int t = tid; t < 16384; t += 512) { const int cp = t & 15, c = (t >> 4) & 15, k = (t >> 8) & 31, dir = t >> 13; const int gi = (i * 2 + dir) * 32 + g;
                const float* cre = in[I_CRE] + ((size_t)gi * 16 + c) * 64; const float* cim = in[I_CIM] + ((size_t)gi * 16 + c) * 64; float s = 0.f;
                for (int n = 0; n < 64; ++n) { const f32x2 p = POW[(size_t)(gi * 64 + n) * 33 + k], b = BBAR[(size_t)(gi * 64 + n) * 16 + cp]; const f32x2 pb = cmul(p, b); s += cre[n] * pb.x - cim[n] * pb.y; }
                KT[t] = s; }
            __syncthreads();
            bf16_t* km = KM + ((size_t)(i * 32 + g) * 512 + q * 128) * 768;
            for (int t = tid; t < 128 * 768; t += 512) { const int col = t % 768, rr = t / 768, ii = q * 8 + (rr >> 4), c = rr & 15; float v;
                if (col < 512) { const int ip = col >> 4, cp = col & 15, k = ii - ip;
                    if (k > 0) v = KT[((0 * 32 + k) * 16 + c) * 16 + cp]; else if (k < 0) v = KT[((1 * 32 - k) * 16 + c) * 16 + cp];
                    else v = KT[(c) * 16 + cp] + KT[((32) * 16 + c) * 16 + cp] + (c == cp ? in[I_S5D][(i * 32 + g) * 16 + c] : 0.f);
                } else { const int comp = col - 512, dir = comp >> 7, im = (comp >> 6) & 1, n = comp & 63; const int gi = (i * 2 + dir) * 32 + g;
                    const f32x2 p = POW[(size_t)(gi * 64 + n) * 33 + (dir == 0 ? ii + 1 : 32 - ii)]; const float cr = in[I_CRE][((size_t)gi * 16 + c) * 64 + n], ci = in[I_CIM][((size_t)gi * 16 + c) * 64 + n];
                    v = im ? -(cr * p.y + ci * p.x) : (cr * p.x - ci * p.y); }
                km[t] = (bf16_t)(cvt_pk_bf16(v, 0.f) & 0xffffu); }
            bf16_t* ms = MS + ((size_t)(i * 32 + g) * 256 + q * 64) * 512;
            { const int dir = q >> 1, im = q & 1; const int gi = (i * 2 + dir) * 32 + g;
              for (int t = tid; t < 64 * 512; t += 512) { const int col = t & 511, n = t >> 9, ip = col >> 4, cp = col & 15;
                const f32x2 p = POW[(size_t)(gi * 64 + n) * 33 + (dir == 0 ? 31 - ip : ip)], b = BBAR[(size_t)(gi * 64 + n) * 16 + cp]; const f32x2 pb = cmul(p, b);
                ms[t] = (bf16_t)(cvt_pk_bf16(im ? pb.y : pb.x, 0.f) & 0xffffu); } }
            __syncthreads();
        }
    }
    SEAM(1);
    if (SITE(2) && IN(2)) { PHASE_BEGIN
        for (int row = gw; row < NTOK; row += NGW) {
            const float* src = row < CTX ? in[I_CTX] + (size_t)row * DM : in[I_X] + (size_t)(row - CTX) * DM; const float* md = MOD + (row < CTX ? 6144 : 0);
#pragma unroll
            for (int j = 0; j < 4; ++j) { const int c = 4 * lane + 256 * j; const f32x4 v = *(const f32x4*)(src + c), sh = *(const f32x4*)(md + c), sc = *(const f32x4*)(md + 1024 + c);
                *(f32x4*)(X + (size_t)row * DM + c) = v; const f32x4 hh = v * (sc + 1.0f) + sh; u32x2 w; w.x = cvt_pk_bf16(hh[0], hh[1]); w.y = cvt_pk_bf16(hh[2], hh[3]); *(u32x2*)(H + (size_t)row * DM + c) = w; } }
    }
    SEAM(2);

#pragma unroll 1
    for (int l = 0; l < 4; ++l) {
        const int pb = 3 + 10 * l, i = l >> 1;
#define modl (MOD + (size_t)l * 2 * 6144)
        if ((l & 1) == 0) {
            if (SITE(3) && IN(pb + 0)) { PHASE_BEGIN pg8::DenseSched S; S.init(H, DM, WIN + (size_t)i * 1048576, DM, NTOK, 1024, 1024, G, bx); pg8::EpiZ E{UP, ZF}; pg8::gemm_phase<pg8::EpiZ, pg8::DenseSched>(ldsl, S, E); }
            SEAM(pb + 0);
            if (SITE(4) && IN(pb + 1)) { PHASE_BEGIN
                f32x2* T = (f32x2*)lds; f32x2* tw = (f32x2*)(lds + 132096);
                if (tid < 64) { float sn, cs; sincospif(-(float)tid * (1.0f / 64.0f), &sn, &cs); tw[tid] = (f32x2){cs, sn}; }
                __syncthreads();
                for (int u = bx; u < 520; u += G) {
                    if (u < 512) { const int l2 = u >> 2, g = u & 3; fft_a_unit(ZF, TT, CTX + l2, 128, g, (float)l2 * (1.0f / 16384.0f), 6.905339660024878e-4f  , T, tw, tid); }
                    else { const int l2 = (u - 512) >> 2, g = u & 3; fft_a_unit(ZF, TT, l2, 2, g, (float)l2 * (1.0f / 256.0f), 5.5242717280199e-3f  , T, tw, tid); }
                }
                __syncthreads();
                pg8::BatchSched S; S.init(UP, (size_t)NCHP * UPW, UPW, MS + (size_t)i * 32 * 256 * 512, (size_t)256 * 512, 512, 3, 1, 32, 512, G, G - 1 - bx);
                pg8::EpiG1 E{SLOC}; pg8::gemm_phase<pg8::EpiG1, pg8::BatchSched>(ldsl, S, E);
            }
            SEAM(pb + 1);
            if (SITE(5) && IN(pb + 2)) { PHASE_BEGIN
                if (bx < 8 && G > 16) s5_scan_thread(bx * 512 + tid, SLOC, APOW + i * 4096, UP);
                else {
                    if (G <= 16) { for (int t = bx * 512 + tid; t < 4096; t += G * 512) s5_scan_thread(t, SLOC, APOW + i * 4096, UP); }
                    f32x2* T = (f32x2*)lds; f32x2* tw = (f32x2*)(lds + 132096);
                    if (tid < 64) { float sn, cs; sincospif(-(float)tid * (1.0f / 64.0f), &sn, &cs); tw[tid] = (f32x2){cs, sn}; }
                    __syncthreads();
                    const int nb = G > 16 ? G - 8 : G, b0 = G > 16 ? bx - 8 : bx;
                    for (int u = b0; u < 516; u += nb) {
                        if (u < 512) { const int k1 = u >> 2, g = u & 3; fft_b_unit(TT, SPEC, CTX + 128 * k1, CTX + k1, g, T, tw, tid); }
                        else { const int g = u - 512;
                            for (int p = tid; p < 2048; p += 512) { const int k1 = p >> 4, kc = (p & 15) * 8; const f32x2* a = TT + (size_t)(2 * k1) * 512 + g * 128 + kc; const f32x2* b = a + 512;
                                u32x4 w0, w1; float s[8], d[8];
#pragma unroll
                                for (int e = 0; e < 8; ++e) { s[e] = a[e].x + b[e].x; d[e] = a[e].x - b[e].x; }
                                w0.x = cvt_pk_bf16(s[0], s[1]); w0.y = cvt_pk_bf16(s[2], s[3]); w0.z = cvt_pk_bf16(s[4], s[5]); w0.w = cvt_pk_bf16(s[6], s[7]);
                                w1.x = cvt_pk_bf16(d[0], d[1]); w1.y = cvt_pk_bf16(d[2], d[3]); w1.z = cvt_pk_bf16(d[4], d[5]); w1.w = cvt_pk_bf16(d[6], d[7]);
                                *(u32x4*)(SPEC + (size_t)k1 * 512 + g * 128 + kc) = w0; *(u32x4*)(SPEC + (size_t)(k1 + 128) * 512 + g * 128 + kc) = w1; } }
                    }
                }
            }
            SEAM(pb + 2);
            if (SITE(6) && IN(pb + 3)) { PHASE_BEGIN
                { pg8::BatchSched S; S.init(UP, (size_t)NCHP * UPW, UPW, KM + (size_t)i * 32 * 512 * 768, (size_t)512 * 768, 768, 3, 2, 32, 768, G, bx);
                  pg8::EpiG2 E{YG}; pg8::gemm_phase<pg8::EpiG2, pg8::BatchSched>(ldsl, S, E); }
                { pg8::DenseSched S; S.init(SPEC, 512, WFN + (size_t)i * 262144, 512, NTOK, 512, 512, G, G - 1 - bx);
                  pg8::EpiBias16 E{CAT, 1024, 512, in[I_FNB] + i * 512, 0}; pg8::gemm_phase<pg8::EpiBias16, pg8::DenseSched>(ldsl, S, E); }
            }
            SEAM(pb + 3);
            if (SITE(7) && IN(pb + 4)) { PHASE_BEGIN pg8::DenseSched S; S.init(YG, 512, WGLU + (size_t)i * 262144, 512, NTOK, 512, 512, G, bx);
                pg8::EpiGLU E{YG, CAT, in[I_BGLU] + i * 512}; pg8::gemm_phase<pg8::EpiGLU, pg8::DenseSched>(ldsl, S, E); }
            SEAM(pb + 4);
            if (SITE(8) && IN(pb + 5)) { PHASE_BEGIN pg8::DenseSched S; S.init(CAT, DM, WOUT + (size_t)i * 1048576, DM, NTOK, 1024, 1024, G, bx);
                pg8::EpiRes E{X, modl + 2 * 1024, modl + 6144 + 2 * 1024}; pg8::gemm_phase<pg8::EpiRes, pg8::DenseSched>(ldsl, S, E); }
            SEAM(pb + 5);
        } else {
            if (SITE(9) && IN(pb + 0)) { PHASE_BEGIN pg8::DenseSched S; S.init(H, DM, WQKV + (size_t)i * 3145728, DM, NTOK, 3072, 1024, G, bx);
                pg8::EpiQKV E{QKV, ROPE}; pg8::gemm_phase<pg8::EpiQKV, pg8::DenseSched>(ldsl, S, E); }
            SEAM(pb + 0);
            if (SITE(10) && IN(pb + 1)) { PHASE_BEGIN
                const int xcd = vcu / (G / 8 > 0 ? G / 8 : 1), loc = vcu % (G / 8 > 0 ? G / 8 : 1), per = G / 8;
                if (G % 8 == 0 && per >= 1) {
                    for (int uu = loc; uu < 130; uu += per) {
                        int hm, row0, seq;
                        if (uu < 128) { hm = 2 * xcd + (uu >> 6); row0 = CTX + (uu & 63) * 256; seq = NTOK; } else { hm = 2 * xcd + (uu - 128); row0 = 0; seq = CTX; }
                        attn::attn_unit(QKV + (size_t)row0 * 3072 + hm * 64, QKV + 1024 + hm * 64, QKV + 2048 + (hm >> 1) * 128, OA + (size_t)row0 * 2048 + hm * 128, 2048, seq, (char*)lds, tid);
                    }
                } else {
                    for (int uu = bx; uu < 1040; uu += G) { int hm, row0, seq;
                        if (uu < 1024) { hm = uu >> 6; row0 = CTX + (uu & 63) * 256; seq = NTOK; } else { hm = uu - 1024; row0 = 0; seq = CTX; }
                        attn::attn_unit(QKV + (size_t)row0 * 3072 + hm * 64, QKV + 1024 + hm * 64, QKV + 2048 + (hm >> 1) * 128, OA + (size_t)row0 * 2048 + hm * 128, 2048, seq, (char*)lds, tid); }
                }
            }
            SEAM(pb + 1);
            if (SITE(11) && IN(pb + 2)) { PHASE_BEGIN
                const float d1 = wave_sum(in[I_LQ1][i * 64 + lane] * in[I_LK1][i * 64 + lane]), d2 = wave_sum(in[I_LQ2][i * 64 + lane] * in[I_LK2][i * 64 + lane]);
                const float lam_init = 0.8f - 0.6f * expf(-0.3f * (float)l), lam = expf(d1) - expf(d2) + lam_init;
                for (int row = gw; row < NTOK; row += NGW) diff_combine_row(row, OA, OB, lam, in[I_SUBG] + i * 128, 1.0f - lam_init, lane);
            }
            SEAM(pb + 2);
            if (SITE(12) && IN(pb + 3)) { PHASE_BEGIN pg8::DenseSched S; S.init(OB, DM, WO + (size_t)i * 1048576, DM, NTOK, 1024, 1024, G, bx);
                pg8::EpiRes E{X, modl + 2 * 1024, modl + 6144 + 2 * 1024}; pg8::gemm_phase<pg8::EpiRes, pg8::DenseSched>(ldsl, S, E); }
            SEAM(pb + 3);
        }
        if (SITE(13) && IN(pb + 6)) { PHASE_BEGIN
            float* wr = (float*)lds;
            for (int t = tid; t < 32768 / 4; t += 512) ((f32x4*)wr)[t] = ((const f32x4*)(RWT + (size_t)l * 32768))[t];
            __syncthreads();
            for (int row = gw; row < NTOK; row += NGW) { const float* md = modl + (row < CTX ? 6144 : 0);
                ln_router_row(row, X, H2, in[I_LNG] + (l * 2) * 1024, in[I_LNB] + (l * 2) * 1024, md + 3 * 1024, md + 4 * 1024, wr, in[I_RB] + l * 32, TOPI, TOPW, TOPS, LIST, CTLW + CW_CNT + l * 32, lane); }
            __syncthreads();
        }
        SEAM(pb + 6);
        if (SITE(14) && IN(pb + 7)) { PHASE_BEGIN
            moe_tiles_to_lds(CTLW + CW_CNT + l * 32, tp, cntl, tid);
            pg8::MoeSched<true> S{H2, WGU + (size_t)l * 32 * 2097152, (size_t)2097152, 1024, DM, DM, 8, G, bx, tp, cntl, LIST};
            pg8::EpiSwiGLU E{ACT, in[I_BG] + (size_t)l * 32768, in[I_BU] + (size_t)l * 32768}; pg8::gemm_phase<pg8::EpiSwiGLU, pg8::MoeSched<true>>(ldsl, S, E);
        }
        SEAM(pb + 7);
        if (SITE(15) && IN(pb + 8)) { PHASE_BEGIN
            moe_tiles_to_lds(CTLW + CW_CNT + l * 32, tp, cntl, tid);
            pg8::MoeSched<false> S{ACT, WD + (size_t)l * 32 * 1048576, (size_t)1048576, 1024, DM, DM, 4, G, bx, tp, cntl, LIST};
            pg8::EpiBias16 E{YD, 1024, 0, in[I_BDN] + (size_t)l * 32768, 1024}; pg8::gemm_phase<pg8::EpiBias16, pg8::MoeSched<false>>(ldsl, S, E);
        }
        SEAM(pb + 8);
        if (SITE(16) && IN(pb + 9)) { PHASE_BEGIN
            moe_tiles_to_lds(CTLW + CW_CNT + l * 32, tp, cntl, tid);
            for (int row = gw; row < NTOK; row += NGW) { const int s = row < CTX ? 1 : 0; const float* md = modl + s * 6144; const float* nmd = MOD + ((size_t)(l + 1) * 2 + s) * 6144;
                moe_combine_row(row, X, YD, TOPI, TOPW, TOPS, tp, md + 5 * 1024, in[I_LNG] + (l * 2 + 1) * 1024, in[I_LNB] + (l * 2 + 1) * 1024, nmd, nmd + 1024, l < 3 ? H : nullptr, l == 3 ? args.out : nullptr, lane); }
        }
        SEAM(pb + 9);
    }
#undef IN
#undef SEAM
}
#undef WGU
#undef WD
#undef WIN
#undef WGLU
#undef WFN
#undef WOUT
#undef WQKV
#undef WO
#undef MS
#undef KM
#undef POW
#undef BBAR
#undef APOW
#undef MOD
#undef PART
#undef ROPE
#undef RWT
#undef X
#undef H
#undef H2
#undef UP
#undef SLOC
#undef ZF
#undef TT
#undef SPEC
#undef YG
#undef CAT
#undef QKV
#undef OA
#undef OB
#undef TOPI
#undef TOPW
#undef TOPS
#undef LIST
#undef ACT
#undef YD
#undef CTLW
#undef PHASE_BEGIN
#undef modl


#ifndef MK_MULTI
#define MK_MULTI 0
#endif
extern "C" void kernel_launch(void* const* d_in, const int* in_sizes, int n_in, void* d_out, int out_size, void* d_ws, size_t ws_size, hipStream_t stream) {
    static int grid = 0;
    if (grid == 0) {
        if (n_in != 37 || out_size != SEQ * DM || ws_size < WS_END) { fprintf(stderr, "kernel_launch: unexpected shapes: n_in %d out %d ws %zu (need %zu)\n", n_in, out_size, ws_size, (size_t)WS_END); grid = -1; return; }
        int dev = 0, cus = 0, per_cu = 0;
        if (hipGetDevice(&dev) != hipSuccess || hipDeviceGetAttribute(&cus, hipDeviceAttributeMultiprocessorCount, dev) != hipSuccess) { grid = -1; return; }
        if (hipFuncSetAttribute((const void*)mega, hipFuncAttributeMaxDynamicSharedMemorySize, LDS_BYTES) != hipSuccess) { fprintf(stderr, "kernel_launch: hipFuncSetAttribute failed\n"); grid = -1; return; }
        if (hipOccupancyMaxActiveBlocksPerMultiprocessor(&per_cu, (const void*)mega, 512, LDS_BYTES) != hipSuccess || per_cu < 1) { fprintf(stderr, "kernel_launch: occupancy query reports %d blocks per CU\n", per_cu); }
        (void)hipGetLastError();
        grid = cus;
    }
    if (grid < 0) return;
    (void)hipMemsetAsync((char*)d_ws + WS_CTL, 0, 2 * MiB, stream);
    Args a{};
    for (int i = 0; i < 37; ++i) a.in[i] = (const float*)d_in[i];
    a.out = (float*)d_out; a.ws = (unsigned char*)d_ws;
#if MK_MULTI
    int li = 0;
    for (int ph = 0; ph < NPHASE; ++ph) {
        if (ph >= 3) { const int l = (ph - 3) / 10, s = (ph - 3) % 10; if ((l & 1) && (s == 4 || s == 5)) continue; }
        a.ph_lo = ph; a.ph_hi = ph + 1; a.li = li++;
        hipLaunchKernelGGL(mega, dim3(grid), dim3(512), LDS_BYTES, stream, a);
    }
#else
    a.ph_lo = 0; a.ph_hi = NPHASE; a.li = 0;
    hipLaunchKernelGGL(mega, dim3(grid), dim3(512), LDS_BYTES, stream, a);
#endif
    const hipError_t le = hipPeekAtLastError();
    if (le != hipSuccess) fprintf(stderr, "kernel_launch: launch failed: %s\n", hipGetErrorName(le));
}
```
